# Optimizing an MI355X kernel written in HIP

```python
import jax
import jax.numpy as jnp
from jax import lax
import numpy as np

D_MODEL = 1024
BATCH = 8
SEQ = 4096
DEPTH = 2

NORM_EPS = 1e-6
MASK_VALUE = -1e30
MIN_GATE = 1e-30
HG_HEADS = 8
HG_DK = 128
HG_DV = 128
HG_WIDTH = HG_HEADS * HG_DK
HG_CHUNK = 32
RW_HEAD_SIZE = 64
RW_HEADS = 16
RW_WIDTH = RW_HEADS * RW_HEAD_SIZE
RW_LORA_W = 64
RW_LORA_A = 64
RW_LORA_G = 128
RW_LORA_V = 32
RW_LNX_EPS = 1e-5 * RW_HEAD_SIZE
RW_IN = 3 * RW_WIDTH + RW_LORA_W + RW_LORA_A + RW_LORA_G
MLA_HEADS = 8
MLA_Q_RANK = 384
MLA_KV_RANK = 256
MLA_NOPE = 128
MLA_ROPE = 64
MLA_V = 128
MLA_WIDTH = MLA_HEADS * MLA_V
ROPE_THETA = 10000.0
Q_BLOCK = 128
N_BRANCH = 3
D_FF = ((-(-8 * D_MODEL // 3) + 255) // 256) * 256
IN_SIZES = (HG_WIDTH, HG_WIDTH, HG_WIDTH, HG_WIDTH, RW_IN, MLA_Q_RANK, MLA_KV_RANK, MLA_ROPE, N_BRANCH * D_MODEL)
IN_WIDTH = sum(IN_SIZES)
IN_SPLITS = tuple(int(c) for c in np.cumsum(IN_SIZES))
RW_SPLITS = tuple(int(c) for c in np.cumsum((RW_WIDTH, RW_WIDTH, RW_WIDTH, RW_LORA_W, RW_LORA_A)))

kernel_name = 'hybrid_hgrn2_rwkv7_mla_gated_block'


def rms_norm(x, g):
    xf = x.astype(jnp.float32)
    y = xf * lax.rsqrt(jnp.mean(xf * xf, axis=-1, keepdims=True) + NORM_EPS)
    return (y * g.astype(jnp.float32)).astype(x.dtype)


def token_shift(z, mu):
    z_prev = jnp.pad(z, ((0, 0), (1, 0), (0, 0)))[:, :-1]
    return z + (z_prev - z) * mu


def rope_angles(positions):
    inv_freq = ROPE_THETA ** (-jnp.arange(0, MLA_ROPE, 2, dtype=jnp.float32) / MLA_ROPE)
    ang = positions.astype(jnp.float32)[..., None] * inv_freq
    return jnp.cos(ang), jnp.sin(ang)


def apply_rope(x, cos, sin):
    x1, x2 = jnp.split(x, 2, axis=-1)
    return jnp.concatenate([x1 * cos - x2 * sin, x1 * sin + x2 * cos], axis=-1).astype(x.dtype)


def hgrn2_mixer(zq, zf, zi, zog, lower_bound, onorm_g):
    B, S, _ = zq.shape
    nc = S // HG_CHUNK
    zf32 = zf.astype(jnp.float32)
    f = lower_bound + (1.0 - lower_bound) * jax.nn.sigmoid(zf32)
    log_f = jnp.log(jnp.maximum(f, MIN_GATE))
    k = (1.0 - lower_bound) * jax.nn.sigmoid(-zf32)

    def chunks(t, d):
        return t.astype(jnp.float32).reshape(B, nc, HG_CHUNK, HG_HEADS, d).transpose(1, 0, 3, 2, 4)

    causal = jnp.tril(jnp.ones((HG_CHUNK, HG_CHUNK), dtype=bool))[:, :, None]

    def chunk_step(state, inp):
        q, kc, v, lf = inp
        b = jnp.cumsum(lf, axis=2)
        diff = b[:, :, :, None, :] - b[:, :, None, :, :]
        rel = jnp.where(causal, jnp.exp(jnp.where(causal, diff, 0.0)), 0.0)
        scores = jnp.einsum('bhtd,bhsd,bhtsd->bhts', q, kc, rel)
        o = jnp.einsum('bhts,bhsv->bhtv', scores, v) + jnp.einsum('bhtd,bhdv->bhtv', q * jnp.exp(b), state)
        b_last = b[:, :, -1:, :]
        state = jnp.exp(b_last[:, :, 0, :, None]) * state + jnp.einsum('bhsd,bhsv->bhdv', kc * jnp.exp(b_last - b), v)
        return state, o

    state0 = jnp.zeros((B, HG_HEADS, HG_DK, HG_DV), jnp.float32)
    _, o = lax.scan(chunk_step, state0, (chunks(zq, HG_DK), chunks(k, HG_DK), chunks(zi, HG_DV), chunks(log_f, HG_DK)))
    o = o.transpose(1, 0, 3, 2, 4).reshape(B, S, HG_HEADS, HG_DV)
    o = rms_norm(o, onorm_g).reshape(B, S, HG_HEADS * HG_DV)
    return (o * jax.nn.silu(zog.astype(jnp.float32))).astype(zq.dtype)


def rwkv7_mixer(zrw, mu, w0, w_up, a0, a_up, g_up, k_k, k_a, r_k, lnx_g, lnx_b, v_first, vres):
    B, S, _ = zrw.shape
    zs = token_shift(zrw, mu).astype(jnp.float32)
    r, k, v, zw, za, zg = jnp.split(zs, RW_SPLITS, axis=-1)
    w_log = -jax.nn.softplus(-(w0 + jnp.tanh(zw) @ w_up)) - 0.5
    decay = jnp.exp(-jnp.exp(w_log))
    a = jax.nn.sigmoid(a0 + za @ a_up)
    g = jax.nn.sigmoid(zg) @ g_up
    if vres is None:
        v_first = v
    else:
        zv, v0, v_up = vres
        v = v + (v_first - v) * jax.nn.sigmoid(v0 + zv @ v_up)

    def heads(t):
        return t.reshape(B, S, RW_HEADS, RW_HEAD_SIZE)

    kk = heads(k * k_k)
    kk = kk * lax.rsqrt(jnp.maximum(jnp.sum(kk * kk, axis=-1, keepdims=True), 1e-24))
    k = k * (1.0 + (a - 1.0) * k_a)
    rh, kh, vh, wh, ah = heads(r), heads(k), heads(v), heads(decay), heads(a)

    def step(state, inp):
        r_t, w_t, k_t, v_t, kk_t, a_t = inp
        sa = jnp.einsum('bhvk,bhk->bhv', state, -kk_t)
        state = (state * w_t[:, :, None, :] + sa[..., None] * (kk_t * a_t)[:, :, None, :]
                 + v_t[..., None] * k_t[:, :, None, :])
        return state, jnp.einsum('bhvk,bhk->bhv', state, r_t)

    state0 = jnp.zeros((B, RW_HEADS, RW_HEAD_SIZE, RW_HEAD_SIZE), jnp.float32)
    xs = tuple(t.transpose(1, 0, 2, 3) for t in (rh, wh, kh, vh, kk, ah))
    _, y = lax.scan(step, state0, xs)
    y = y.transpose(1, 0, 2, 3)
    mean = jnp.mean(y, axis=-1, keepdims=True)
    var = jnp.mean(jnp.square(y - mean), axis=-1, keepdims=True)
    y = ((y - mean) * lax.rsqrt(var + RW_LNX_EPS)).reshape(B, S, RW_WIDTH) * lnx_g + lnx_b
    bonus = jnp.sum(rh * kh * r_k.reshape(RW_HEADS, RW_HEAD_SIZE), axis=-1, keepdims=True) * vh
    y = (y + bonus.reshape(B, S, RW_WIDTH)) * g
    return y.astype(zrw.dtype), v_first


def mla_mixer(zcq, zckv, zkr, cos, sin, q_norm_g, w_uq, kv_norm_g, w_ukv):
    B, S, _ = zcq.shape
    q = (rms_norm(zcq, q_norm_g) @ w_uq).reshape(B, S, MLA_HEADS, MLA_NOPE + MLA_ROPE)
    q_nope = q[..., :MLA_NOPE]
    q_rope = apply_rope(q[..., MLA_NOPE:], cos[:, :, None, :], sin[:, :, None, :])
    kv = (rms_norm(zckv, kv_norm_g) @ w_ukv).reshape(B, S, MLA_HEADS, MLA_NOPE + MLA_V)
    k_nope = kv[..., :MLA_NOPE].transpose(0, 2, 1, 3)
    v = kv[..., MLA_NOPE:].transpose(0, 2, 1, 3)
    k_rope = apply_rope(zkr, cos, sin)
    nb = S // Q_BLOCK

    def q_blocks(t):
        return t.reshape(B, nb, Q_BLOCK, MLA_HEADS, t.shape[-1]).transpose(1, 0, 3, 2, 4)

    scale = (MLA_NOPE + MLA_ROPE) ** -0.5
    key_pos = jnp.arange(S)

    def attend_block(inp):
        qn, qr, blk = inp
        s = jnp.einsum('bhqd,bhkd->bhqk', qn, k_nope) + jnp.einsum('bhqd,bkd->bhqk', qr, k_rope)
        s = s.astype(jnp.float32) * scale
        q_pos = blk * Q_BLOCK + jnp.arange(Q_BLOCK)
        s = jnp.where(key_pos[None, :] <= q_pos[:, None], s, MASK_VALUE)
        p = jax.nn.softmax(s, axis=-1).astype(v.dtype)
        return jnp.einsum('bhqk,bhkd->bhqd', p, v)

    o = lax.map(attend_block, (q_blocks(q_nope), q_blocks(q_rope), jnp.arange(nb)))
    return o.transpose(1, 0, 3, 2, 4).reshape(B, S, MLA_WIDTH)


def setup_inputs(seed: int = 0) -> dict:
    key = jax.random.key(seed)
    ks = iter(jax.random.split(key, 48))
    L = DEPTH
    LV = DEPTH - 1
    D = D_MODEL

    def nrm(shape, scale):
        return jax.random.normal(next(ks), shape, jnp.float32) * scale

    def gain(shape):
        return 1.0 + nrm(shape, 0.05)

    x = nrm((BATCH, SEQ, D), 1.0)
    offsets = jax.random.randint(next(ks), (BATCH, 1), 0, 1024, dtype=jnp.int32)
    positions = offsets + jnp.arange(SEQ, dtype=jnp.int32)[None, :]
    return {
        'x': x,
        'positions': positions,
        'hgrn_lb_logits': nrm((L, HG_WIDTH), 0.5),
        'mix_pre_g': gain((L, D)),
        'mix_post_g': gain((L, D)),
        'ffn_pre_g': gain((L, D)),
        'ffn_post_g': gain((L, D)),
        'w_in': nrm((L, D, IN_WIDTH), D ** -0.5),
        'w_vres_down': nrm((LV, D, RW_LORA_V), D ** -0.5),
        'hgrn_onorm_g': gain((L, HG_DV)),
        'rwkv_mu': jax.random.uniform(next(ks), (L, RW_IN), jnp.float32, 0.1, 0.9),
        'rwkv_vres_mu': jax.random.uniform(next(ks), (LV, RW_LORA_V), jnp.float32, 0.1, 0.9),
        'rwkv_w0': nrm((L, RW_WIDTH), 0.5),
        'rwkv_w_up': nrm((L, RW_LORA_W, RW_WIDTH), 0.1),
        'rwkv_a0': nrm((L, RW_WIDTH), 0.2),
        'rwkv_a_up': nrm((L, RW_LORA_A, RW_WIDTH), 0.5 * RW_LORA_A ** -0.5),
        'rwkv_g_up': nrm((L, RW_LORA_G, RW_WIDTH), RW_LORA_G ** -0.5),
        'rwkv_v0': nrm((LV, RW_WIDTH), 0.2),
        'rwkv_v_up': nrm((LV, RW_LORA_V, RW_WIDTH), 0.5 * RW_LORA_V ** -0.5),
        'rwkv_k_k': 0.85 + nrm((L, RW_WIDTH), 0.05),
        'rwkv_k_a': 1.0 + nrm((L, RW_WIDTH), 0.05),
        'rwkv_r_k': nrm((L, RW_WIDTH), 0.1),
        'rwkv_lnx_g': gain((L, RW_WIDTH)),
        'rwkv_lnx_b': nrm((L, RW_WIDTH), 0.02),
        'mla_q_norm_g': gain((L, MLA_Q_RANK)),
        'mla_w_uq': nrm((L, MLA_Q_RANK, MLA_HEADS * (MLA_NOPE + MLA_ROPE)), MLA_Q_RANK ** -0.5),
        'mla_kv_norm_g': gain((L, MLA_KV_RANK)),
        'mla_w_ukv': nrm((L, MLA_KV_RANK, MLA_HEADS * (MLA_NOPE + MLA_V)), MLA_KV_RANK ** -0.5),
        'w_branch': nrm((L, N_BRANCH, HG_WIDTH, D), HG_WIDTH ** -0.5),
        'w_out': nrm((L, D, D), D ** -0.5),
        'w_ffn_in': nrm((L, D, 2 * D_FF), D ** -0.5),
        'w_ffn_out': nrm((L, D_FF, D), D_FF ** -0.5),
    }


def reference(x, positions, hgrn_lb_logits, mix_pre_g, mix_post_g, ffn_pre_g, ffn_post_g, w_in, w_vres_down,
              hgrn_onorm_g, rwkv_mu, rwkv_vres_mu, rwkv_w0, rwkv_w_up, rwkv_a0, rwkv_a_up, rwkv_g_up, rwkv_v0,
              rwkv_v_up, rwkv_k_k, rwkv_k_a, rwkv_r_k, rwkv_lnx_g, rwkv_lnx_b, mla_q_norm_g, mla_w_uq,
              mla_kv_norm_g, mla_w_ukv, w_branch, w_out, w_ffn_in, w_ffn_out):
    probs = jax.nn.softmax(hgrn_lb_logits.astype(jnp.float32), axis=0)
    lower_bounds = jnp.cumsum(probs, axis=0) - probs[0]
    cos, sin = rope_angles(positions)
    v_first = None
    for l in range(DEPTH):
        h = rms_norm(x, mix_pre_g[l])
        w_cols = w_in[l] if l == 0 else jnp.concatenate([w_in[l], w_vres_down[l - 1]], axis=1)
        z = h @ w_cols
        zq, zf, zi, zog, zrw, zcq, zckv, zkr, zgate, zvres = jnp.split(z, IN_SPLITS, axis=-1)

        o_hg = hgrn2_mixer(zq, zf, zi, zog, lower_bounds[l], hgrn_onorm_g[l])
        vres = None if l == 0 else (token_shift(zvres, rwkv_vres_mu[l - 1]), rwkv_v0[l - 1], rwkv_v_up[l - 1])
        o_rw, v_first = rwkv7_mixer(zrw, rwkv_mu[l], rwkv_w0[l], rwkv_w_up[l], rwkv_a0[l], rwkv_a_up[l],
                                    rwkv_g_up[l], rwkv_k_k[l], rwkv_k_a[l], rwkv_r_k[l], rwkv_lnx_g[l],
                                    rwkv_lnx_b[l], v_first, vres)
        o_mla = mla_mixer(zcq, zckv, zkr, cos, sin, mla_q_norm_g[l], mla_w_uq[l], mla_kv_norm_g[l], mla_w_ukv[l])

        g_hg, g_rw, g_mla = jnp.split(jax.nn.sigmoid(zgate), N_BRANCH, axis=-1)
        merged = (g_hg * (o_hg @ w_branch[l, 0]) + g_rw * (o_rw @ w_branch[l, 1])
                  + g_mla * (o_mla @ w_branch[l, 2]))
        x = x + rms_norm(merged @ w_out[l], mix_post_g[l])

        h = rms_norm(x, ffn_pre_g[l])
        gate, up = jnp.split(h @ w_ffn_in[l], 2, axis=-1)
        x = x + rms_norm((jax.nn.silu(gate) * up) @ w_ffn_out[l], ffn_post_g[l])
    return x
```

```cpp
#include <hip/hip_runtime.h>
#include <cstdio>
#include <cstdint>

#define LAS __attribute__((address_space(3)))
typedef unsigned short bf16_t;
typedef short bf16x8 __attribute__((ext_vector_type(8)));
typedef float f32x4 __attribute__((ext_vector_type(4)));
typedef float f32x2 __attribute__((ext_vector_type(2)));
typedef unsigned u32x4 __attribute__((ext_vector_type(4)));
typedef unsigned u32x2 __attribute__((ext_vector_type(2)));

constexpr int T = 32768, D = 1024, SEQ = 4096, NBATCH = 8;
constexpr int IN_W = 11200;
constexpr float NORM_EPS = 1e-6f;

__device__ __forceinline__ float bf2f(unsigned v) { return __uint_as_float(v << 16); }
__device__ __forceinline__ unsigned f2bf(float f) { unsigned u = __float_as_uint(f); return (u + 0x7fffu + ((u >> 16) & 1u)) >> 16; }
__device__ __forceinline__ unsigned pk2(float lo, float hi) { return f2bf(lo) | (f2bf(hi) << 16); }
__device__ __forceinline__ float lo_bf(unsigned w) { return __uint_as_float(w << 16); }
__device__ __forceinline__ float hi_bf(unsigned w) { return __uint_as_float(w & 0xffff0000u); }
__device__ __forceinline__ float sigmoidf_(float x) { return 1.0f / (1.0f + __expf(-x)); }
__device__ __forceinline__ float wave_sum(float v) {
#pragma unroll
    for (int o = 1; o < 64; o <<= 1) v += __shfl_xor(v, o);
    return v;
}

namespace pg8 {
constexpr int BM = 256, BK = 64, HALF = 128, HTB = HALF * BK * 2, STAGE_BYTES = 8 * HTB, NXCD = 8, WGM = 8;
__host__ __device__ __forceinline__ int lds_byte(int r, int c) { const int st = (r >> 4) * 2 + (c >> 5), rr = r & 15, cc = c & 31, ob = rr * 64 + cc * 2; return st * 1024 + (ob ^ (((ob >> 9) & 1) << 5)); }
__host__ __device__ __forceinline__ void stage_rc(int b, int& R, int& C) { const int st = b / 1024, sb = b % 1024, swz = sb ^ (((sb >> 9) & 1) << 5); R = (st >> 1) * 16 + swz / 64; C = (st & 1) * 32 + (swz % 64) / 2; }
__host__ __device__ __forceinline__ int perm32(int rho) { const int n = rho >> 4, i = rho & 15; return 8 * (i >> 2) + 4 * n + (i & 3); }

struct Unit { int pm, pn; };
struct Gemm { const bf16_t* A; const bf16_t* Bt; int M, N, K, lda; };

struct StaticOrder {
    int nM, nN, nwg, G, c;
    __host__ __device__ void init(int M, int N, int G_, int c_) { nM = M / BM; nN = N / BM; nwg = nM * nN; G = G_; c = c_; }
    __host__ __device__ bool next(int i, Unit& u) const {
        const long L = (long)i * G + c; if (L >= nwg) return false;
        int wgid = (int)L; { const int q = nwg / NXCD, r = nwg % NXCD, xcd = wgid % NXCD, off = wgid / NXCD; wgid = (xcd < r ? xcd * (q + 1) : r * (q + 1) + (xcd - r) * q) + off; }
        const int nig = WGM * nN, gid = wgid / nig, fm = gid * WGM, gsz = (nM - fm) < WGM ? (nM - fm) : WGM;
        u.pm = fm + ((wgid % nig) % gsz); u.pn = (wgid % nig) / gsz; return true;
    }
    __device__ __forceinline__ void a_ready(const Unit&) const {}
    __device__ __forceinline__ void done(const Unit&) const {}
};
__device__ __forceinline__ unsigned cvt_pk_bf16(float lo, float hi) { unsigned r; asm volatile("v_cvt_pk_bf16_f32 %0, %1, %2" : "=v"(r) : "v"(lo), "v"(hi)); return r; }

template <class Epi, class Sched, bool ALIGN_EPI = false, bool SP2 = false>
__device__ __forceinline__ void gemm_phase(LAS unsigned char* lds, const Gemm g, const Sched& S, const Epi& E) {
    const int tid = threadIdx.x, wid = __builtin_amdgcn_readfirstlane(tid >> 6), lane = tid & 63, wr = wid >> 2, wc = wid & 3, fr = lane & 15, fq = lane >> 4;
    const int K = g.K, nt = K / BK, lda = g.lda;
    unsigned voffA[2], voffB[2];
#pragma unroll
    for (int i = 0; i < 2; ++i) { int R, C; stage_rc(tid * 16 + i * 8192, R, C); const int Rb = Epi::PERM ? ((R & ~31) + perm32(R & 31)) : R;
        voffA[i] = (unsigned)(R * lda + C) * 2u; voffB[i] = (unsigned)(Rb * K + C) * 2u; }
    const size_t kstep = (size_t)(BK * 2);
    const size_t hstepA = (size_t)HALF * lda * 2, hstepB = (size_t)HALF * K * 2;
    const size_t tstepA = 2 * hstepA, tstepB = 2 * hstepB;
    const unsigned ldsw = (unsigned)wid * 1024u;
    const int aoff = lds_byte(wr * 64 + fr, fq * 8), boff = lds_byte(wc * 32 + fr, fq * 8);
#define PG8_SA(b, h) (((b) * 2 + (h)) * HTB)
#define PG8_SB(b, h) ((4 + (b) * 2 + (h)) * HTB)
#define PG8_STAGE(bufoff, gbase, voff) do { _Pragma("unroll") for (int _i = 0; _i < 2; ++_i) \
        __builtin_amdgcn_global_load_lds((const unsigned*)((const char*)(gbase) + (voff)[_i]), (LAS unsigned*)(lds + (bufoff) + ldsw + _i * 8192), 16, 0, 0); } while (0)
#define PG8_LDA(dst, b, h) do { _Pragma("unroll") for (int m = 0; m < 4; ++m) _Pragma("unroll") for (int k = 0; k < 2; ++k) dst[m][k] = *(const LAS bf16x8*)(lds + PG8_SA(b, h) + aoff + m * 2048 + k * 1024); } while (0)
#define PG8_LDB(dst, b, h) do { _Pragma("unroll") for (int n = 0; n < 2; ++n) _Pragma("unroll") for (int k = 0; k < 2; ++k) dst[n][k] = *(const LAS bf16x8*)(lds + PG8_SB(b, h) + boff + n * 2048 + k * 1024); } while (0)
#define PG8_MMA(ai, bj, At, Bt) do { __builtin_amdgcn_s_setprio(1); _Pragma("unroll") for (int m = 0; m < 4; ++m) _Pragma("unroll") for (int n = 0; n < 2; ++n) _Pragma("unroll") for (int k = 0; k < 2; ++k) \
        acc[ai][bj][m][n] = __builtin_amdgcn_mfma_f32_16x16x32_bf16(Bt[n][k], At[m][k], acc[ai][bj][m][n], 0, 0, 0); __builtin_amdgcn_s_setprio(0); } while (0)
#define PG8_WAIT_V(n) asm volatile("s_waitcnt vmcnt(" #n ")" ::: "memory")
#define PG8_WAIT_L(n) asm volatile("s_waitcnt lgkmcnt(" #n ")" ::: "memory")
#define PG8_BAR __builtin_amdgcn_s_barrier()
#define PG8_SCHED __builtin_amdgcn_sched_barrier(0)
    Unit cur, nxt; int ui = 0;
    if (!S.next(0, cur)) return;
    f32x4 acc[2][2][4][2];
#pragma unroll
    for (int a = 0; a < 2; ++a)
#pragma unroll
        for (int b = 0; b < 2; ++b)
#pragma unroll
            for (int m = 0; m < 4; ++m)
#pragma unroll
                for (int n = 0; n < 2; ++n) acc[a][b][m][n] = (f32x4){0.f, 0.f, 0.f, 0.f};
    bf16x8 At[4][2], B0[2][2], B1[2][2];
    const char* cA = (const char*)g.A + (size_t)cur.pm * tstepA; const char* cB = (const char*)g.Bt + (size_t)cur.pn * tstepB;
    S.a_ready(cur);
    if constexpr (SP2) {
        PG8_STAGE(PG8_SB(0, 0), cB, voffB); PG8_STAGE(PG8_SB(0, 1), cB + hstepB, voffB); PG8_STAGE(PG8_SA(0, 0), cA, voffA); PG8_STAGE(PG8_SA(0, 1), cA + hstepA, voffA);
        if (wr == 1) PG8_BAR;
        PG8_WAIT_V(2); PG8_BAR;
        PG8_STAGE(PG8_SB(1, 0), cB + kstep, voffB); PG8_STAGE(PG8_SA(1, 0), cA + kstep, voffA); PG8_STAGE(PG8_SB(1, 1), cB + hstepB + kstep, voffB);
        PG8_WAIT_V(6); PG8_BAR;
    } else {
        PG8_STAGE(PG8_SB(0, 0), cB, voffB); PG8_STAGE(PG8_SA(0, 0), cA, voffA); PG8_STAGE(PG8_SB(0, 1), cB + hstepB, voffB); PG8_STAGE(PG8_SA(0, 1), cA + hstepA, voffA);
        if (wr == 1) PG8_BAR;
        PG8_WAIT_V(4); PG8_BAR;
        PG8_STAGE(PG8_SB(1, 0), cB + kstep, voffB); PG8_STAGE(PG8_SA(1, 0), cA + kstep, voffA); PG8_STAGE(PG8_SB(1, 1), cB + hstepB + kstep, voffB);
        PG8_WAIT_V(6); PG8_BAR;
    }
    for (;;) {
        const bool has_next = S.next(ui + 1, nxt);
        const char* nA = has_next ? (const char*)g.A + (size_t)nxt.pm * tstepA : cA; const char* nB = has_next ? (const char*)g.Bt + (size_t)nxt.pn * tstepB : cB;
        for (int t = 0; t < nt; t += 2) {
            const bool last = (t == nt - 2);
            const char* a1 = cA + (size_t)(t + 1) * kstep;
            const char* a2 = last ? nA : cA + (size_t)(t + 2) * kstep; const char* b2 = last ? nB : cB + (size_t)(t + 2) * kstep;
            const char* a3 = a2 + kstep; const char* b3 = b2 + kstep;
            if (last && has_next) S.a_ready(nxt);
            if constexpr (SP2) {
            PG8_LDB(B0, 0, 0); PG8_LDB(B1, 0, 1); PG8_SCHED; PG8_LDA(At, 0, 0); PG8_STAGE(PG8_SA(1, 1), a1 + hstepA, voffA);
            PG8_WAIT_V(8); PG8_WAIT_L(0); PG8_BAR; PG8_MMA(0, 0, At, B0); PG8_MMA(0, 1, At, B1); PG8_BAR; PG8_SCHED;
            PG8_LDA(At, 0, 1); PG8_STAGE(PG8_SB(0, 0), b2, voffB); PG8_STAGE(PG8_SB(0, 1), b2 + hstepB, voffB); PG8_STAGE(PG8_SA(0, 0), a2, voffA);
            PG8_WAIT_V(8); PG8_WAIT_L(0); PG8_BAR; PG8_MMA(1, 0, At, B0); PG8_MMA(1, 1, At, B1); PG8_BAR; PG8_SCHED;
            PG8_LDB(B0, 1, 0); PG8_LDB(B1, 1, 1); PG8_SCHED; PG8_LDA(At, 1, 0); PG8_STAGE(PG8_SA(0, 1), a2 + hstepA, voffA);
            PG8_WAIT_V(8); PG8_WAIT_L(0); PG8_BAR; PG8_MMA(0, 0, At, B0); PG8_MMA(0, 1, At, B1); PG8_BAR; PG8_SCHED;
            PG8_LDA(At, 1, 1); PG8_STAGE(PG8_SB(1, 0), b3, voffB); PG8_STAGE(PG8_SB(1, 1), b3 + hstepB, voffB); PG8_STAGE(PG8_SA(1, 0), a3, voffA);
            PG8_WAIT_V(8); PG8_WAIT_L(0); PG8_BAR; PG8_MMA(1, 0, At, B0); PG8_MMA(1, 1, At, B1); PG8_BAR; PG8_SCHED;
            } else {
            PG8_LDB(B0, 0, 0); PG8_SCHED; PG8_LDA(At, 0, 0); PG8_STAGE(PG8_SA(1, 1), a1 + hstepA, voffA);
            PG8_WAIT_L(8); PG8_BAR; PG8_WAIT_L(0); PG8_MMA(0, 0, At, B0); PG8_BAR; PG8_SCHED;
            PG8_LDB(B1, 0, 1); PG8_STAGE(PG8_SB(0, 0), b2, voffB);
            PG8_BAR; PG8_WAIT_L(0); PG8_MMA(0, 1, At, B1); PG8_BAR;
            PG8_LDA(At, 0, 1); PG8_STAGE(PG8_SA(0, 0), a2, voffA);
            PG8_BAR; PG8_WAIT_L(0); PG8_MMA(1, 0, At, B0); PG8_BAR; PG8_SCHED;
            PG8_STAGE(PG8_SB(0, 1), b2 + hstepB, voffB);
            PG8_WAIT_V(6); PG8_BAR; PG8_MMA(1, 1, At, B1); PG8_BAR;
            PG8_LDB(B0, 1, 0); PG8_SCHED; PG8_LDA(At, 1, 0); PG8_STAGE(PG8_SA(0, 1), a2 + hstepA, voffA);
            PG8_WAIT_L(8); PG8_BAR; PG8_WAIT_L(0); PG8_MMA(0, 0, At, B0); PG8_BAR; PG8_SCHED;
            PG8_LDB(B1, 1, 1); PG8_STAGE(PG8_SB(1, 0), b3, voffB);
            PG8_BAR; PG8_WAIT_L(0); PG8_MMA(0, 1, At, B1); PG8_BAR;
            PG8_LDA(At, 1, 1); PG8_STAGE(PG8_SA(1, 0), a3, voffA);
            PG8_BAR; PG8_WAIT_L(0); PG8_MMA(1, 0, At, B0); PG8_BAR; PG8_SCHED;
            PG8_STAGE(PG8_SB(1, 1), b3 + hstepB, voffB);
            PG8_WAIT_V(6); PG8_BAR; PG8_MMA(1, 1, At, B1); PG8_BAR;
            }
        }
        if constexpr (ALIGN_EPI) { if (wr == 0) PG8_BAR; }
        E(acc, cur, wr, wc, fr, fq);
        if (!has_next) break;
#pragma unroll
        for (int a = 0; a < 2; ++a)
#pragma unroll
            for (int b = 0; b < 2; ++b)
#pragma unroll
                for (int m = 0; m < 4; ++m)
#pragma unroll
                    for (int n = 0; n < 2; ++n) acc[a][b][m][n] = (f32x4){0.f, 0.f, 0.f, 0.f};
        cur = nxt; cA = nA; cB = nB; ++ui;
        if constexpr (ALIGN_EPI) { if (wr == 1) PG8_BAR; }
    }
    PG8_WAIT_V(0);
    if constexpr (!ALIGN_EPI) { if (wr == 0) PG8_BAR; }
    PG8_BAR;
#undef PG8_SA
#undef PG8_SB
#undef PG8_STAGE
#undef PG8_LDA
#undef PG8_LDB
#undef PG8_MMA
#undef PG8_WAIT_V
#undef PG8_WAIT_L
#undef PG8_BAR
#undef PG8_SCHED
}
}
using pg8::Unit; using pg8::Gemm; using pg8::cvt_pk_bf16;

__device__ __forceinline__ u32x4 pack8(const f32x4 a, const f32x4 b) { u32x4 w; w.x = cvt_pk_bf16(a[0], a[1]); w.y = cvt_pk_bf16(a[2], a[3]); w.z = cvt_pk_bf16(b[0], b[1]); w.w = cvt_pk_bf16(b[2], b[3]); return w; }
__device__ __forceinline__ void unpack8(const u32x4 w, f32x4& a, f32x4& b) { a = (f32x4){lo_bf(w.x), hi_bf(w.x), lo_bf(w.y), hi_bf(w.y)}; b = (f32x4){lo_bf(w.z), hi_bf(w.z), lo_bf(w.w), hi_bf(w.w)}; }
__device__ __forceinline__ f32x4 sig4(f32x4 x) { return (f32x4){sigmoidf_(x[0]), sigmoidf_(x[1]), sigmoidf_(x[2]), sigmoidf_(x[3])}; }

struct EpiRoute {
    static constexpr bool PERM = true;
    bf16_t* p0; long seg_stride; bf16_t* plast; int ld0, ldlast, tps, lastseg; float scale; int pad;
    __device__ __forceinline__ void operator()(const f32x4 (&acc)[2][2][4][2], const Unit& u, int wr, int wc, int fr, int fq) const {
        const int seg = u.pn / tps, colt = (u.pn - seg * tps) * 256; const bool lastp = seg >= lastseg;
        bf16_t* base = lastp ? plast : p0 + (long)seg * seg_stride; const int ldc = lastp ? ldlast : ld0;
        const int row0 = u.pm * 256 + wr * 64 + fr, col0 = colt + wc * 32 + 8 * fq;
#pragma unroll
        for (int ai = 0; ai < 2; ++ai)
#pragma unroll
            for (int m = 0; m < 4; ++m) { bf16_t* rowp = base + (size_t)(row0 + ai * 128 + m * 16) * ldc + col0;
#pragma unroll
                for (int bj = 0; bj < 2; ++bj) *(u32x4*)(rowp + bj * 128) = pack8(acc[ai][bj][m][0] * scale, acc[ai][bj][m][1] * scale); }
    }
};
struct EpiQ {
    static constexpr bool PERM = true;
    bf16_t* qn; bf16_t* qr; const float* rope; float qscale; int pad;
    __device__ __forceinline__ void operator()(const f32x4 (&acc)[2][2][4][2], const Unit& u, int wr, int wc, int fr, int fq) const {
        const int row0 = u.pm * 256 + wr * 64 + fr;
        if (u.pn < 4) {
            const int col0 = u.pn * 256 + wc * 32 + 8 * fq;
#pragma unroll
            for (int ai = 0; ai < 2; ++ai)
#pragma unroll
                for (int m = 0; m < 4; ++m) { bf16_t* rowp = qn + (size_t)(row0 + ai * 128 + m * 16) * 1024 + col0;
#pragma unroll
                    for (int bj = 0; bj < 2; ++bj) *(u32x4*)(rowp + bj * 128) = pack8(acc[ai][bj][m][0] * qscale, acc[ai][bj][m][1] * qscale); }
        } else {
            const int h = (u.pn - 4) * 4 + wc, i0 = 8 * fq;
#pragma unroll
            for (int ai = 0; ai < 2; ++ai)
#pragma unroll
                for (int m = 0; m < 4; ++m) { const int row = row0 + ai * 128 + m * 16; const float* rp = rope + (size_t)row * 64 + i0;
                    const f32x4 c0 = *(const f32x4*)(rp), c1 = *(const f32x4*)(rp + 4), s0 = *(const f32x4*)(rp + 32), s1 = *(const f32x4*)(rp + 36);
                    const f32x4 x10 = acc[ai][0][m][0], x11 = acc[ai][0][m][1], x20 = acc[ai][1][m][0], x21 = acc[ai][1][m][1];
                    bf16_t* op = qr + (size_t)row * 512 + h * 64 + i0;
                    *(u32x4*)(op) = pack8((x10 * c0 - x20 * s0) * qscale, (x11 * c1 - x21 * s1) * qscale);
                    *(u32x4*)(op + 32) = pack8((x10 * s0 + x20 * c0) * qscale, (x11 * s1 + x21 * c1) * qscale); }
        }
    }
};
template <int MODE> struct EpiEw {
    static constexpr bool PERM = true;
    bf16_t* O; const bf16_t* X;
    __device__ __forceinline__ void operator()(const f32x4 (&acc)[2][2][4][2], const Unit& u, int wr, int wc, int fr, int fq) const {
        const int row0 = u.pm * 256 + wr * 64 + fr, col0 = u.pn * 256 + wc * 32 + 8 * fq;
#pragma unroll
        for (int ai = 0; ai < 2; ++ai)
#pragma unroll
            for (int m = 0; m < 4; ++m) { const size_t off = (size_t)(row0 + ai * 128 + m * 16) * 1024 + col0;
#pragma unroll
                for (int bj = 0; bj < 2; ++bj) { f32x4 a = acc[ai][bj][m][0], b = acc[ai][bj][m][1];
                    if (MODE == 0) { a = sig4(a); b = sig4(b); }
                    if (MODE == 1) { f32x4 oa, ob; unpack8(*(const u32x4*)(O + off + bj * 128), oa, ob); a = oa * a * sig4(a); b = ob * b * sig4(b); }
                    if (MODE == 2) { f32x4 xa, xb; unpack8(*(const u32x4*)(X + off + bj * 128), xa, xb); a = xa * a; b = xb * b; }
                    if (MODE == 3) { f32x4 xa, xb, oa, ob; unpack8(*(const u32x4*)(X + off + bj * 128), xa, xb); unpack8(*(const u32x4*)(O + off + bj * 128), oa, ob); a = oa + xa * a; b = ob + xb * b; }
                    *(u32x4*)(O + off + bj * 128) = pack8(a, b); } }
    }
};
struct EpiSwiglu {
    static constexpr bool PERM = true;
    bf16_t* Hh;
    __device__ __forceinline__ void operator()(const f32x4 (&acc)[2][2][4][2], const Unit& u, int wr, int wc, int fr, int fq) const {
        const int row0 = u.pm * 256 + wr * 64 + fr, col0 = u.pn * 128 + wc * 32 + 8 * fq;
#pragma unroll
        for (int ai = 0; ai < 2; ++ai)
#pragma unroll
            for (int m = 0; m < 4; ++m) { const f32x4 g0 = acc[ai][0][m][0], g1 = acc[ai][0][m][1];
                *(u32x4*)(Hh + (size_t)(row0 + ai * 128 + m * 16) * 2816 + col0) = pack8(g0 * sig4(g0) * acc[ai][1][m][0], g1 * sig4(g1) * acc[ai][1][m][1]); }
    }
};

template <class Epi> __global__ __launch_bounds__(512, 2) void k_gemm(Gemm g, Epi E) {
    extern __shared__ __attribute__((aligned(16))) unsigned char shm[];
    pg8::StaticOrder S; S.init(g.M, g.N, (int)gridDim.x, (int)blockIdx.x);
    pg8::gemm_phase<Epi, pg8::StaticOrder, true, true>((LAS unsigned char*)shm, g, S, E);
}

constexpr size_t MiB = 1u << 20, U64 = 64 * MiB;
constexpr size_t WS_CTL = 0, WS_ROPE = 1 * MiB, WS_W = 10 * MiB;
constexpr size_t WS_H = 1 * U64, WS_VF = 2 * U64, WS_MG = 3 * U64, WS_XR = 4 * U64, WS_ZA = 5 * U64, WS_END = 8 * U64;
constexpr size_t KE = 1024;
constexpr size_t W_RW = 0, W_HG = W_RW + 3584 * KE, W_OG = W_HG + 3072 * KE, W_MLA = W_OG + 1024 * KE, W_GATE = W_MLA + 768 * KE, W_UQ = W_GATE + 3072 * KE,
                 W_UKV = W_UQ + 1536 * 384, W_BR = W_UKV + 2048 * 256, W_OUT = W_BR + 3072 * KE, W_FI = W_OUT + 1024 * KE, W_FO = W_FI + 5632 * KE, W_TOTAL = W_FO + 1024 * 2816;
static_assert(WS_W + W_TOTAL * 2 <= U64, "weights fit region 0");

struct Params { const float* in[32]; float* out; unsigned char* ws; };

__device__ __forceinline__ int wmap(int mapid, int n0) {
    switch (mapid) {
        case 1: { const int tile = n0 >> 8, bj = (n0 & 255) >> 7, hl = (n0 & 127) >> 5; return (tile * 4 + hl) * 192 + 128 + bj * 32; }
        case 2: return (n0 >> 7) * 192 + (n0 & 127);
        case 3: return (n0 >> 7) * 256 + (n0 & 127);
        case 4: return (n0 >> 7) * 256 + 128 + (n0 & 127);
        case 5: { const int pn = n0 >> 8, bj = (n0 & 255) >> 7, j = n0 & 127; return bj * 2816 + 128 * pn + j; }
        default: return n0;
    }
}
__device__ __forceinline__ void transpose_item(const float* W, int ld, int K, int col0, int mapid, bf16_t* WT, LAS float* scr, int item, int nblk, int lane) {
    const int kb = item / nblk, nb = item % nblk, k0 = 64 * kb, n0 = 32 * nb;
    if (W) { const int sc = col0 + wmap(mapid, n0);
#pragma unroll 8
        for (int i = 0; i < 32; ++i) { const int kk = 2 * i + (lane >> 5); scr[kk * 33 + (lane & 31)] = W[(size_t)(k0 + kk) * ld + sc + (lane & 31)]; }
    } else {
#pragma unroll 8
        for (int i = 0; i < 32; ++i) { const int kk = 2 * i + (lane >> 5); scr[kk * 33 + (lane & 31)] = 0.f; }
    }
    asm volatile("s_waitcnt vmcnt(0) lgkmcnt(0)" ::: "memory");
    const int c = lane & 7;
#pragma unroll
    for (int j = 0; j < 4; ++j) { const int n = (lane >> 3) + 8 * j; const LAS float* s = scr + (8 * c) * 33 + n;
        u32x4 o; o.x = pk2(s[0 * 33], s[1 * 33]); o.y = pk2(s[2 * 33], s[3 * 33]); o.z = pk2(s[4 * 33], s[5 * 33]); o.w = pk2(s[6 * 33], s[7 * 33]);
        *(u32x4*)(WT + (size_t)(n0 + n) * K + k0 + 8 * c) = o; }
    asm volatile("s_waitcnt lgkmcnt(0)" ::: "memory");
}
__device__ __forceinline__ void wjob(const float* src, int ld, int col0, int K, int nrows, int mapid, bf16_t* dst, LAS float* scr, int gw, int ngw, int lane) {
    const int nblk = nrows / 32, nitems = (K / 64) * nblk;
    for (int it = gw; it < nitems; it += ngw) transpose_item(src, ld, K, col0, mapid, dst, scr, it, nblk, lane);
}
__device__ __forceinline__ void phase_weights(const Params& p, int l, LAS unsigned char* lds) {
    const int wave = threadIdx.x >> 6, lane = threadIdx.x & 63, gw = blockIdx.x * (blockDim.x >> 6) + wave, ngw = gridDim.x * (blockDim.x >> 6);
    LAS float* scr = (LAS float*)(lds + wave * 8704);
    bf16_t* WB = (bf16_t*)(p.ws + WS_W);
    const float* w_in = p.in[7] + (size_t)l * 1024 * IN_W;
    wjob(w_in, IN_W, 4096, 1024, 3328, 0, WB + W_RW, scr, gw, ngw, lane);
    wjob(l == 1 ? p.in[8] : nullptr, 32, 0, 1024, 32, 0, WB + W_RW + 3328 * KE, scr, gw, ngw, lane);
    wjob(nullptr, 0, 0, 1024, 224, 0, WB + W_RW + 3360 * KE, scr, gw, ngw, lane);
    wjob(w_in, IN_W, 0, 1024, 3072, 0, WB + W_HG, scr, gw, ngw, lane);
    wjob(w_in, IN_W, 3072, 1024, 1024, 0, WB + W_OG, scr, gw, ngw, lane);
    wjob(w_in, IN_W, 7424, 1024, 704, 0, WB + W_MLA, scr, gw, ngw, lane);
    wjob(nullptr, 0, 0, 1024, 64, 0, WB + W_MLA + 704 * KE, scr, gw, ngw, lane);
    wjob(w_in, IN_W, 8128, 1024, 3072, 0, WB + W_GATE, scr, gw, ngw, lane);
    const float* wuq = p.in[25] + (size_t)l * 384 * 1536;
    wjob(wuq, 1536, 0, 384, 1024, 2, WB + W_UQ, scr, gw, ngw, lane);
    wjob(wuq, 1536, 0, 384, 512, 1, WB + W_UQ + 1024 * 384, scr, gw, ngw, lane);
    const float* wukv = p.in[27] + (size_t)l * 256 * 2048;
    wjob(wukv, 2048, 0, 256, 1024, 3, WB + W_UKV, scr, gw, ngw, lane);
    wjob(wukv, 2048, 0, 256, 1024, 4, WB + W_UKV + 1024 * 256, scr, gw, ngw, lane);
    for (int b = 0; b < 3; ++b) wjob(p.in[28] + ((size_t)l * 3 + b) * KE * KE, 1024, 0, 1024, 1024, 0, WB + W_BR + b * KE * KE, scr, gw, ngw, lane);
    wjob(p.in[29] + (size_t)l * KE * KE, 1024, 0, 1024, 1024, 0, WB + W_OUT, scr, gw, ngw, lane);
    wjob(p.in[30] + (size_t)l * 1024 * 5632, 5632, 0, 1024, 5632, 5, WB + W_FI, scr, gw, ngw, lane);
    wjob(p.in[31] + (size_t)l * 2816 * 1024, 1024, 0, 2816, 1024, 0, WB + W_FO, scr, gw, ngw, lane);
}
__global__ __launch_bounds__(512, 2) void k_weights(Params p, int l) {
    extern __shared__ __attribute__((aligned(16))) unsigned char shm[];
    phase_weights(p, l, (LAS unsigned char*)shm);
}

__global__ void k_rope(Params p) {
    const int idx = blockIdx.x * blockDim.x + threadIdx.x; if (idx >= T * 32) return;
    const int row = idx >> 5, i = idx & 31;
    const float inv = powf(10000.0f, -(float)(2 * i) / 64.0f);
    const float ang = (float)((const int*)p.in[1])[row] * inv;
    float s, c; sincosf(ang, &s, &c);
    float* rope = (float*)(p.ws + WS_ROPE);
    rope[(size_t)row * 64 + i] = c; rope[(size_t)row * 64 + 32 + i] = s;
}

__device__ __forceinline__ void load_row_f32(const float* r, int lane, f32x4 (&v)[4]) {
#pragma unroll
    for (int j = 0; j < 4; ++j) v[j] = *(const f32x4*)(r + 4 * lane + 256 * j);
}
__device__ __forceinline__ void load_row_bf16(const bf16_t* r, int lane, f32x4 (&v)[4]) {
#pragma unroll
    for (int j = 0; j < 4; ++j) { const u32x2 w = *(const u32x2*)(r + 4 * lane + 256 * j); v[j] = (f32x4){lo_bf(w.x), hi_bf(w.x), lo_bf(w.y), hi_bf(w.y)}; }
}
__device__ __forceinline__ void store_row_bf16(bf16_t* r, int lane, const f32x4 (&v)[4]) {
#pragma unroll
    for (int j = 0; j < 4; ++j) { u32x2 w; w.x = pk2(v[j][0], v[j][1]); w.y = pk2(v[j][2], v[j][3]); *(u32x2*)(r + 4 * lane + 256 * j) = w; }
}
__device__ __forceinline__ float row_rstd(const f32x4 (&v)[4]) {
    float s = 0.f;
#pragma unroll
    for (int j = 0; j < 4; ++j) s += (v[j][0] * v[j][0] + v[j][1] * v[j][1]) + (v[j][2] * v[j][2] + v[j][3] * v[j][3]);
    return rsqrtf(wave_sum(s) * (1.0f / 1024.0f) + NORM_EPS);
}
__global__ void k_norm0(const float* x, const float* g, bf16_t* h) {
    const int lane = threadIdx.x & 63, row = blockIdx.x * (blockDim.x >> 6) + (threadIdx.x >> 6); if (row >= T) return;
    f32x4 v[4], gg[4]; load_row_f32(x + (size_t)row * D, lane, v); load_row_f32(g, lane, gg);
    const float rs = row_rstd(v);
#pragma unroll
    for (int j = 0; j < 4; ++j) v[j] = v[j] * rs * gg[j];
    store_row_bf16(h + (size_t)row * D, lane, v);
}
__global__ void k_normres(const bf16_t* y, const float* xo_f32, const bf16_t* xo_bf, const float* gpost, bf16_t* xr_out, float* xf_out, const float* gnext, bf16_t* h) {
    const int lane = threadIdx.x & 63, row = blockIdx.x * (blockDim.x >> 6) + (threadIdx.x >> 6); if (row >= T) return;
    f32x4 v[4], xo[4], gg[4]; load_row_bf16(y + (size_t)row * D, lane, v); load_row_f32(gpost, lane, gg);
    if (xo_f32) load_row_f32(xo_f32 + (size_t)row * D, lane, xo); else load_row_bf16(xo_bf + (size_t)row * D, lane, xo);
    const float rs = row_rstd(v);
#pragma unroll
    for (int j = 0; j < 4; ++j) v[j] = xo[j] + v[j] * rs * gg[j];
    if (xf_out) {
#pragma unroll
        for (int j = 0; j < 4; ++j) *(f32x4*)(xf_out + (size_t)row * D + 4 * lane + 256 * j) = v[j];
    } else store_row_bf16(xr_out + (size_t)row * D, lane, v);
    if (gnext) { load_row_f32(gnext, lane, gg); const float rs2 = row_rstd(v);
#pragma unroll
        for (int j = 0; j < 4; ++j) v[j] = v[j] * rs2 * gg[j];
        store_row_bf16(h + (size_t)row * D, lane, v); }
}

__global__ void k_mla_prep(bf16_t* zmla, const float* gq, const float* gkv, const float* rope, bf16_t* krope) {
    const int lane = threadIdx.x & 63, row = blockIdx.x * (blockDim.x >> 6) + (threadIdx.x >> 6); if (row >= T) return;
    bf16_t* z = zmla + (size_t)row * 768;
    float q[6]; float s = 0.f;
#pragma unroll
    for (int j = 0; j < 6; ++j) { q[j] = bf2f(z[lane + 64 * j]); s += q[j] * q[j]; }
    const float rq = rsqrtf(wave_sum(s) * (1.0f / 384.0f) + NORM_EPS);
#pragma unroll
    for (int j = 0; j < 6; ++j) z[lane + 64 * j] = (bf16_t)f2bf(q[j] * rq * gq[lane + 64 * j]);
    float c[4]; s = 0.f;
#pragma unroll
    for (int j = 0; j < 4; ++j) { c[j] = bf2f(z[384 + lane + 64 * j]); s += c[j] * c[j]; }
    const float rc = rsqrtf(wave_sum(s) * (1.0f / 256.0f) + NORM_EPS);
#pragma unroll
    for (int j = 0; j < 4; ++j) z[384 + lane + 64 * j] = (bf16_t)f2bf(c[j] * rc * gkv[lane + 64 * j]);
    if (lane < 32) { const float x1 = bf2f(z[640 + lane]), x2 = bf2f(z[672 + lane]); const float cs = rope[(size_t)row * 64 + lane], sn = rope[(size_t)row * 64 + 32 + lane];
        krope[(size_t)row * 64 + lane] = (bf16_t)f2bf(x1 * cs - x2 * sn); krope[(size_t)row * 64 + 32 + lane] = (bf16_t)f2bf(x1 * sn + x2 * cs); }
}

__global__ __launch_bounds__(256) void k_attn_slow(bf16_t* qn, const bf16_t* qr, const bf16_t* kn, const bf16_t* krope, const bf16_t* vv) {
    const int bh = blockIdx.x >> 4, qb = blockIdx.x & 15, b = bh >> 3, h = bh & 7;
    const int t = qb * 256 + threadIdx.x; const size_t row = (size_t)b * SEQ + t;
    unsigned qp[96];
#pragma unroll
    for (int i = 0; i < 64; ++i) qp[i] = ((const unsigned*)(qn + row * 1024 + h * 128))[i];
#pragma unroll
    for (int i = 0; i < 32; ++i) qp[64 + i] = ((const unsigned*)(qr + row * 512 + h * 64))[i];
    float o[128];
#pragma unroll
    for (int i = 0; i < 128; ++i) o[i] = 0.f;
    float mx = -1e30f, l = 0.f;
    const int jend = qb * 256 + 256;
    for (int j = 0; j < jend; ++j) {
        const size_t kr = (size_t)b * SEQ + j;
        const unsigned* kp = (const unsigned*)(kn + kr * 1024 + h * 128); const unsigned* krp = (const unsigned*)(krope + kr * 64); const unsigned* vp = (const unsigned*)(vv + kr * 1024 + h * 128);
        float s = 0.f;
#pragma unroll
        for (int i = 0; i < 64; ++i) { const unsigned kw = kp[i]; s += lo_bf(qp[i]) * lo_bf(kw) + hi_bf(qp[i]) * hi_bf(kw); }
#pragma unroll
        for (int i = 0; i < 32; ++i) { const unsigned kw = krp[i]; s += lo_bf(qp[64 + i]) * lo_bf(kw) + hi_bf(qp[64 + i]) * hi_bf(kw); }
        if (j <= t) {
            const float mn = fmaxf(mx, s), al = exp2f(mx - mn), pr = exp2f(s - mn);
            l = l * al + pr; mx = mn;
#pragma unroll
            for (int i = 0; i < 64; ++i) { const unsigned vw = vp[i]; o[2 * i] = o[2 * i] * al + pr * lo_bf(vw); o[2 * i + 1] = o[2 * i + 1] * al + pr * hi_bf(vw); }
        }
    }
    const float inv = 1.0f / l;
    unsigned* op = (unsigned*)(qn + row * 1024 + h * 128);
#pragma unroll
    for (int i = 0; i < 64; ++i) op[i] = pk2(o[2 * i] * inv, o[2 * i + 1] * inv);
}

__global__ void k_hgrn_prep(bf16_t* zf, const float* lbl, int l) {
    const size_t idx = ((size_t)blockIdx.x * blockDim.x + threadIdx.x) * 2; if (idx >= (size_t)T * 1024) return;
    const int c = (int)(idx & 1023);
    const unsigned w = *(const unsigned*)(zf + idx); float r[2];
#pragma unroll
    for (int e = 0; e < 2; ++e) { const float z = e ? hi_bf(w) : lo_bf(w); float lb = 0.f;
        if (l == 1) { const float l0 = lbl[c + e], l1 = lbl[1024 + c + e]; lb = 1.0f / (1.0f + __expf(l0 - l1)); }
        const float f = lb + (1.0f - lb) * sigmoidf_(z); r[e] = __logf(fmaxf(f, 1e-30f)); }
    *(unsigned*)(zf + idx) = pk2(r[0], r[1]);
}
__global__ __launch_bounds__(128) void k_hgrn_slow(const bf16_t* zq, const bf16_t* lf, const bf16_t* zi, bf16_t* ohg) {
    const int b = blockIdx.x >> 3, h = blockIdx.x & 7, v = threadIdx.x;
    __shared__ float sf[16][128], sq[16][128];
    float S[128];
#pragma unroll
    for (int k = 0; k < 128; ++k) S[k] = 0.f;
    for (int t0 = 0; t0 < SEQ; t0 += 16) {
        __syncthreads();
        for (int e = threadIdx.x; e < 16 * 128; e += 128) { const int tt = e >> 7, k = e & 127; const size_t off = ((size_t)b * SEQ + t0 + tt) * 1024 + h * 128 + k;
            sf[tt][k] = __expf(bf2f(lf[off])); sq[tt][k] = bf2f(zq[off]); }
        __syncthreads();
        for (int tt = 0; tt < 16; ++tt) {
            const size_t off = ((size_t)b * SEQ + t0 + tt) * 1024 + h * 128 + v;
            const float iv = bf2f(zi[off]); float o = 0.f;
#pragma unroll
            for (int k = 0; k < 128; ++k) { const float f = sf[tt][k]; S[k] = f * S[k] + (1.0f - f) * iv; o += sq[tt][k] * S[k]; }
            ohg[off] = (bf16_t)f2bf(o);
        }
    }
}
__global__ void k_hgrn_post(bf16_t* ohg, const float* g) {
    const int lane = threadIdx.x & 63, row = blockIdx.x * (blockDim.x >> 6) + (threadIdx.x >> 6); if (row >= T) return;
    bf16_t* o = ohg + (size_t)row * 1024;
    for (int h = 0; h < 8; ++h) { const unsigned w = *(const unsigned*)(o + h * 128 + 2 * lane); const float a = lo_bf(w), c = hi_bf(w);
        const float rs = rsqrtf(wave_sum(a * a + c * c) * (1.0f / 128.0f) + NORM_EPS);
        *(unsigned*)(o + h * 128 + 2 * lane) = pk2(a * rs * g[2 * lane], c * rs * g[2 * lane + 1]); }
}

struct RwkvP { const bf16_t *zr, *zk, *zv, *zl; bf16_t* vf; bf16_t* out; const float *mu, *vmu, *w0, *wup, *a0, *aup, *gup, *v0, *vup, *kk_, *ka, *rk, *lng, *lnb; int layer; };
__global__ __launch_bounds__(64) void k_rwkv_slow(RwkvP P) {
    extern __shared__ float sh[];
    float* Lw = sh;
    float* La = Lw + 64 * 64;
    float* Lg = La + 64 * 64;
    float* Lv = Lg + 128 * 64;
    float* s_lw = Lv + 32 * 64;
    float* s_la = s_lw + 64; float* s_lg = s_la + 64; float* s_lv = s_lg + 128;
    float* s_r = s_lv + 32; float* s_w = s_r + 64; float* s_k = s_w + 64; float* s_kk = s_k + 64; float* s_ka = s_kk + 64;
    const int b = blockIdx.x >> 4, h = blockIdx.x & 15, j = threadIdx.x, c = h * 64 + j;
    for (int i = 0; i < 64; ++i) { Lw[i * 64 + j] = P.wup[(size_t)i * 1024 + c]; La[i * 64 + j] = P.aup[(size_t)i * 1024 + c]; }
    for (int i = 0; i < 128; ++i) Lg[i * 64 + j] = P.gup[(size_t)i * 1024 + c];
    if (P.layer == 1) for (int i = 0; i < 32; ++i) Lv[i * 64 + j] = P.vup[(size_t)i * 1024 + c];
    const float mu_r = P.mu[c], mu_k = P.mu[1024 + c], mu_v = P.mu[2048 + c], mu_w = P.mu[3072 + j], mu_a = P.mu[3136 + j], mu_g0 = P.mu[3200 + j], mu_g1 = P.mu[3264 + j];
    const float mu_vr = (P.layer == 1 && j < 32) ? P.vmu[j] : 0.f;
    const float w0 = P.w0[c], a0 = P.a0[c], v0 = P.layer == 1 ? P.v0[c] : 0.f, k_k = P.kk_[c], k_a = P.ka[c], r_k = P.rk[c], lng = P.lng[c], lnb = P.lnb[c];
    float S[64];
#pragma unroll
    for (int k = 0; k < 64; ++k) S[k] = 0.f;
    float pr = 0.f, pk = 0.f, pv = 0.f, plw = 0.f, pla = 0.f, plg0 = 0.f, plg1 = 0.f, plv = 0.f;
    __syncthreads();
    for (int t = 0; t < SEQ; ++t) {
        const size_t row = (size_t)b * SEQ + t;
        const float zr = bf2f(P.zr[row * 1024 + c]), zk = bf2f(P.zk[row * 1024 + c]), zv = bf2f(P.zv[row * 1024 + c]);
        const float lw = bf2f(P.zl[row * 512 + j]), la = bf2f(P.zl[row * 512 + 64 + j]), lg0 = bf2f(P.zl[row * 512 + 128 + j]), lg1 = bf2f(P.zl[row * 512 + 192 + j]);
        const float lv = (j < 32) ? bf2f(P.zl[row * 512 + 256 + j]) : 0.f;
        const float r = zr + (pr - zr) * mu_r; float k = zk + (pk - zk) * mu_k; float v = zv + (pv - zv) * mu_v;
        s_lw[j] = tanhf(lw + (plw - lw) * mu_w); s_la[j] = la + (pla - la) * mu_a;
        s_lg[j] = sigmoidf_(lg0 + (plg0 - lg0) * mu_g0); s_lg[64 + j] = sigmoidf_(lg1 + (plg1 - lg1) * mu_g1);
        if (j < 32) s_lv[j] = lv + (plv - lv) * mu_vr;
        pr = zr; pk = zk; pv = zv; plw = lw; pla = la; plg0 = lg0; plg1 = lg1; plv = lv;
        __syncthreads();
        float wl = w0, al = a0, g = 0.f, vl = v0;
#pragma unroll 4
        for (int i = 0; i < 64; ++i) { wl += s_lw[i] * Lw[i * 64 + j]; al += s_la[i] * La[i * 64 + j]; }
#pragma unroll 4
        for (int i = 0; i < 128; ++i) g += s_lg[i] * Lg[i * 64 + j];
        if (P.layer == 1) {
#pragma unroll 4
            for (int i = 0; i < 32; ++i) vl += s_lv[i] * Lv[i * 64 + j];
            const float vf = bf2f(P.vf[row * 1024 + c]); v = v + (vf - v) * sigmoidf_(vl);
        } else P.vf[row * 1024 + c] = (bf16_t)f2bf(v);
        const float nx = -wl, sp = fmaxf(nx, 0.f) + log1pf(__expf(-fabsf(nx)));
        const float decay = __expf(-__expf(-sp - 0.5f));
        const float a = sigmoidf_(al);
        const float kkv = k * k_k; const float nrm = wave_sum(kkv * kkv); const float kk = kkv * rsqrtf(fmaxf(nrm, 1e-24f));
        k = k * (1.0f + (a - 1.0f) * k_a);
        s_r[j] = r; s_w[j] = decay; s_k[j] = k; s_kk[j] = kk; s_ka[j] = kk * a;
        const float bon = wave_sum(r * k * r_k);
        __syncthreads();
        float sa = 0.f;
#pragma unroll
        for (int q = 0; q < 64; q += 4) { const f32x4 kq = *(const f32x4*)(s_kk + q); sa -= S[q] * kq[0] + S[q + 1] * kq[1] + S[q + 2] * kq[2] + S[q + 3] * kq[3]; if ((q & 15) == 12) asm volatile("" ::: "memory"); }
        float y = 0.f;
#pragma unroll
        for (int q = 0; q < 64; q += 4) { const f32x4 wq = *(const f32x4*)(s_w + q), aq = *(const f32x4*)(s_ka + q), kq = *(const f32x4*)(s_k + q), rq = *(const f32x4*)(s_r + q);
#pragma unroll
            for (int e = 0; e < 4; ++e) { S[q + e] = S[q + e] * wq[e] + sa * aq[e] + v * kq[e]; y += S[q + e] * rq[e]; }
            asm volatile("" ::: "memory"); }
        const float mean = wave_sum(y) * (1.0f / 64.0f); const float dv = y - mean; const float var = wave_sum(dv * dv) * (1.0f / 64.0f);
        const float yn = dv * rsqrtf(var + 64e-5f) * lng + lnb;
        P.out[row * 1024 + c] = (bf16_t)f2bf((yn + bon * v) * g);
    }
}

template <class Epi> static void launch_gemm(hipStream_t st, const bf16_t* A, int lda, const bf16_t* Bt, int N, int K, const Epi& E) {
    static bool attr = false;
    if (!attr) { (void)hipFuncSetAttribute((const void*)k_gemm<Epi>, hipFuncAttributeMaxDynamicSharedMemorySize, 131072); attr = true; }
    Gemm g; g.A = A; g.Bt = Bt; g.M = T; g.N = N; g.K = K; g.lda = lda;
    hipLaunchKernelGGL(k_gemm<Epi>, dim3(256), dim3(512), 131072, st, g, E);
}

extern "C" void kernel_launch(void* const* d_in, const int* in_sizes, int n_in, void* d_out, int out_size, void* d_ws, size_t ws_size, hipStream_t stream) {
    if (n_in != 32 || ws_size < WS_END || out_size != T * D) { fprintf(stderr, "kernel_launch: unexpected shapes (n_in %d ws %zu out %d)\n", n_in, ws_size, out_size); return; }
    Params p{};
    for (int i = 0; i < 32; ++i) p.in[i] = (const float*)d_in[i];
    p.out = (float*)d_out; p.ws = (unsigned char*)d_ws;
    unsigned char* ws = (unsigned char*)d_ws;
    bf16_t* WB = (bf16_t*)(ws + WS_W);
    bf16_t* H = (bf16_t*)(ws + WS_H); bf16_t* VF = (bf16_t*)(ws + WS_VF); bf16_t* MG = (bf16_t*)(ws + WS_MG); bf16_t* XR = (bf16_t*)(ws + WS_XR);
    bf16_t* ZA = (bf16_t*)(ws + WS_ZA); bf16_t* ZB = (bf16_t*)d_out;
    float* rope = (float*)(ws + WS_ROPE);
    const size_t TU = (size_t)T * 1024;
    static bool attr = false;
    if (!attr) { (void)hipFuncSetAttribute((const void*)k_weights, hipFuncAttributeMaxDynamicSharedMemorySize, 8 * 8704);
                 (void)hipFuncSetAttribute((const void*)k_rwkv_slow, hipFuncAttributeMaxDynamicSharedMemorySize, 96 * 1024); attr = true; }
    const float qscale = 0.07216878364870322f * 1.4426950408889634f;
    hipLaunchKernelGGL(k_rope, dim3(T * 32 / 256), dim3(256), 0, stream, p);
    hipLaunchKernelGGL(k_norm0, dim3(T / 4), dim3(256), 0, stream, p.in[0], p.in[3], H);
    for (int l = 0; l < 2; ++l) {
        hipLaunchKernelGGL(k_weights, dim3(256), dim3(512), 8 * 8704, stream, p, l);
        bf16_t* zmla = ZB; bf16_t* krope = ZB + (size_t)T * 768; bf16_t* qn = ZA; bf16_t* qr = ZB + TU; bf16_t* kn = ZA + TU; bf16_t* vv = ZA + 2 * TU;
        { EpiRoute E{zmla, 0, zmla, 768, 768, 16, 99, 1.0f, 0}; launch_gemm(stream, H, 1024, WB + W_MLA, 768, 1024, E); }
        hipLaunchKernelGGL(k_mla_prep, dim3(T / 4), dim3(256), 0, stream, zmla, p.in[24] + l * 384, p.in[26] + l * 256, rope, krope);
        { EpiQ E{qn, qr, rope, qscale, 0}; launch_gemm(stream, zmla, 768, WB + W_UQ, 1536, 384, E); }
        { EpiRoute E{kn, (long)TU, kn, 1024, 1024, 4, 99, 1.0f, 0}; launch_gemm(stream, zmla + 384, 768, WB + W_UKV, 2048, 256, E); }
        hipLaunchKernelGGL(k_attn_slow, dim3(64 * 16), dim3(256), 0, stream, qn, qr, kn, krope, vv);
        { bf16_t* GT = ZB;
          EpiEw<0> Eg{GT, nullptr}; launch_gemm(stream, H, 1024, WB + W_GATE + 2 * KE * KE, 1024, 1024, Eg);
          EpiEw<2> Eb{MG, GT}; launch_gemm(stream, qn, 1024, WB + W_BR + 2 * KE * KE, 1024, 1024, Eb); }
        { bf16_t* zr = ZA; bf16_t* zk = ZA + TU; bf16_t* zv = ZA + 2 * TU; bf16_t* zl = ZB; bf16_t* orw = ZB + TU;
          EpiRoute E{zr, (long)TU, zl, 1024, 512, 4, 3, 1.0f, 0}; launch_gemm(stream, H, 1024, WB + W_RW, 3584, 1024, E);
          RwkvP R{}; R.zr = zr; R.zk = zk; R.zv = zv; R.zl = zl; R.vf = VF; R.out = orw; R.mu = p.in[10] + l * 3328; R.vmu = p.in[11]; R.w0 = p.in[12] + l * 1024; R.wup = p.in[13] + (size_t)l * 64 * 1024;
          R.a0 = p.in[14] + l * 1024; R.aup = p.in[15] + (size_t)l * 64 * 1024; R.gup = p.in[16] + (size_t)l * 128 * 1024; R.v0 = p.in[17]; R.vup = p.in[18];
          R.kk_ = p.in[19] + l * 1024; R.ka = p.in[20] + l * 1024; R.rk = p.in[21] + l * 1024; R.lng = p.in[22] + l * 1024; R.lnb = p.in[23] + l * 1024; R.layer = l;
          hipLaunchKernelGGL(k_rwkv_slow, dim3(128), dim3(64), 96 * 1024, stream, R);
          bf16_t* GT = ZA;
          EpiEw<0> Eg{GT, nullptr}; launch_gemm(stream, H, 1024, WB + W_GATE + 1 * KE * KE, 1024, 1024, Eg);
          EpiEw<3> Eb{MG, GT}; launch_gemm(stream, orw, 1024, WB + W_BR + 1 * KE * KE, 1024, 1024, Eb); }
        { bf16_t* zq = ZA; bf16_t* zf = ZA + TU; bf16_t* zi = ZA + 2 * TU; bf16_t* ohg = ZB;
          EpiRoute E{zq, (long)TU, zq, 1024, 1024, 4, 99, 1.0f, 0}; launch_gemm(stream, H, 1024, WB + W_HG, 3072, 1024, E);
          hipLaunchKernelGGL(k_hgrn_prep, dim3((unsigned)(TU / 2 / 256)), dim3(256), 0, stream, zf, p.in[2], l);
          hipLaunchKernelGGL(k_hgrn_slow, dim3(64), dim3(128), 0, stream, zq, zf, zi, ohg);
          hipLaunchKernelGGL(k_hgrn_post, dim3(T / 4), dim3(256), 0, stream, ohg, p.in[9] + l * 128);
          EpiEw<1> Eo{ohg, nullptr}; launch_gemm(stream, H, 1024, WB + W_OG, 1024, 1024, Eo);
          bf16_t* GT = ZA;
          EpiEw<0> Eg{GT, nullptr}; launch_gemm(stream, H, 1024, WB + W_GATE, 1024, 1024, Eg);
          EpiEw<3> Eb{MG, GT}; launch_gemm(stream, ohg, 1024, WB + W_BR, 1024, 1024, Eb); }
        { bf16_t* y = ZA;
          EpiRoute E{y, 0, y, 1024, 1024, 16, 99, 1.0f, 0}; launch_gemm(stream, MG, 1024, WB + W_OUT, 1024, 1024, E);
          hipLaunchKernelGGL(k_normres, dim3(T / 4), dim3(256), 0, stream, y, l == 0 ? p.in[0] : (const float*)nullptr, XR, p.in[4] + l * 1024, XR, (float*)nullptr, p.in[5] + l * 1024, H);
          bf16_t* hid = ZA;
          EpiSwiglu Es{hid}; launch_gemm(stream, H, 1024, WB + W_FI, 5632, 1024, Es);
          bf16_t* y2 = MG;
          EpiRoute E2{y2, 0, y2, 1024, 1024, 16, 99, 1.0f, 0}; launch_gemm(stream, hid, 2816, WB + W_FO, 1024, 2816, E2);
          if (l == 0) hipLaunchKernelGGL(k_normres, dim3(T / 4), dim3(256), 0, stream, y2, (const float*)nullptr, XR, p.in[6] + l * 1024, XR, (float*)nullptr, p.in[3] + 1024, H);
          else hipLaunchKernelGGL(k_normres, dim3(T / 4), dim3(256), 0, stream, y2, (const float*)nullptr, XR, p.in[6] + l * 1024, (bf16_t*)nullptr, (float*)d_out, (const float*)nullptr, (bf16_t*)nullptr); }
    }
}
static_assert(sizeof(EpiRoute) == 48 && sizeof(EpiQ) == 32 && sizeof(Gemm) == 32 && sizeof(EpiEw<0>) == 16 && sizeof(EpiSwiglu) == 8, "no padding bytes in by-value kernel arguments");
```

```cpp
#include <hip/hip_runtime.h>
#include <cstdio>
#include <cstdint>

#define LAS __attribute__((address_space(3)))
typedef unsigned short bf16_t;
typedef short bf16x8 __attribute__((ext_vector_type(8)));
typedef float f32x4 __attribute__((ext_vector_type(4)));
typedef float f32x2 __attribute__((ext_vector_type(2)));
typedef unsigned u32x4 __attribute__((ext_vector_type(4)));
typedef unsigned u32x2 __attribute__((ext_vector_type(2)));

constexpr int T = 32768, D = 1024, SEQ = 4096, NBATCH = 8;
constexpr int IN_W = 11200;
constexpr float NORM_EPS = 1e-6f;

__device__ __forceinline__ float bf2f(unsigned v) { return __uint_as_float(v << 16); }
__device__ __forceinline__ unsigned f2bf(float f) { unsigned u = __float_as_uint(f); return (u + 0x7fffu + ((u >> 16) & 1u)) >> 16; }
__device__ __forceinline__ unsigned pk2(float lo, float hi) { return f2bf(lo) | (f2bf(hi) << 16); }
__device__ __forceinline__ float lo_bf(unsigned w) { return __uint_as_float(w << 16); }
__device__ __forceinline__ float hi_bf(unsigned w) { return __uint_as_float(w & 0xffff0000u); }
__device__ __forceinline__ float sigmoidf_(float x) { return 1.0f / (1.0f + __expf(-x)); }
__device__ __forceinline__ float wave_sum(float v) {
#pragma unroll
    for (int o = 1; o < 64; o <<= 1) v += __shfl_xor(v, o);
    return v;
}

namespace pg8 {
constexpr int BM = 256, BK = 64, HALF = 128, HTB = HALF * BK * 2, STAGE_BYTES = 8 * HTB, NXCD = 8, WGM = 8;
__host__ __device__ __forceinline__ int lds_byte(int r, int c) { const int st = (r >> 4) * 2 + (c >> 5), rr = r & 15, cc = c & 31, ob = rr * 64 + cc * 2; return st * 1024 + (ob ^ (((ob >> 9) & 1) << 5)); }
__host__ __device__ __forceinline__ void stage_rc(int b, int& R, int& C) { const int st = b / 1024, sb = b % 1024, swz = sb ^ (((sb >> 9) & 1) << 5); R = (st >> 1) * 16 + swz / 64; C = (st & 1) * 32 + (swz % 64) / 2; }
__host__ __device__ __forceinline__ int perm32(int rho) { const int n = rho >> 4, i = rho & 15; return 8 * (i >> 2) + 4 * n + (i & 3); }

struct Unit { int pm, pn; };
struct Gemm { const bf16_t* A; const bf16_t* Bt; int M, N, K, lda; };

struct StaticOrder {
    int nM, nN, nwg, G, c;
    __host__ __device__ void init(int M, int N, int G_, int c_) { nM = M / BM; nN = N / BM; nwg = nM * nN; G = G_; c = c_; }
    __host__ __device__ bool next(int i, Unit& u) const {
        const long L = (long)i * G + c; if (L >= nwg) return false;
        int wgid = (int)L; { const int q = nwg / NXCD, r = nwg % NXCD, xcd = wgid % NXCD, off = wgid / NXCD; wgid = (xcd < r ? xcd * (q + 1) : r * (q + 1) + (xcd - r) * q) + off; }
        const int nig = WGM * nN, gid = wgid / nig, fm = gid * WGM, gsz = (nM - fm) < WGM ? (nM - fm) : WGM;
        u.pm = fm + ((wgid % nig) % gsz); u.pn = (wgid % nig) / gsz; return true;
    }
    __device__ __forceinline__ void a_ready(const Unit&) const {}
    __device__ __forceinline__ void done(const Unit&) const {}
};
typedef __bf16 bf16x2_t __attribute__((ext_vector_type(2)));
__device__ __forceinline__ unsigned cvt_pk_bf16(float lo, float hi) { f32x2 v = {lo, hi}; bf16x2_t b = __builtin_convertvector(v, bf16x2_t); return __builtin_bit_cast(unsigned, b); }

template <class Epi, class Sched, bool ALIGN_EPI = false, bool SP2 = false>
__device__ __forceinline__ void gemm_phase(LAS unsigned char* lds, const Gemm g, const Sched& S, const Epi& E) {
    const int tid = threadIdx.x, wid = __builtin_amdgcn_readfirstlane(tid >> 6), lane = tid & 63, wr = wid >> 2, wc = wid & 3, fr = lane & 15, fq = lane >> 4;
    const int K = g.K, nt = K / BK, lda = g.lda;
    unsigned voffA[2], voffB[2];
#pragma unroll
    for (int i = 0; i < 2; ++i) { int R, C; stage_rc(tid * 16 + i * 8192, R, C); const int Rb = Epi::PERM ? ((R & ~31) + perm32(R & 31)) : R;
        voffA[i] = (unsigned)(R * lda + C) * 2u; voffB[i] = (unsigned)(Rb * K + C) * 2u; }
    const size_t kstep = (size_t)(BK * 2);
    const size_t hstepA = (size_t)HALF * lda * 2, hstepB = (size_t)HALF * K * 2;
    const size_t tstepA = 2 * hstepA, tstepB = 2 * hstepB;
    const unsigned ldsw = (unsigned)wid * 1024u;
    const int aoff = lds_byte(wr * 64 + fr, fq * 8), boff = lds_byte(wc * 32 + fr, fq * 8);
#define PG8_SA(b, h) (((b) * 2 + (h)) * HTB)
#define PG8_SB(b, h) ((4 + (b) * 2 + (h)) * HTB)
#define PG8_STAGE(bufoff, gbase, voff) do { _Pragma("unroll") for (int _i = 0; _i < 2; ++_i) \
        __builtin_amdgcn_global_load_lds((const unsigned*)((const char*)(gbase) + (voff)[_i]), (LAS unsigned*)(lds + (bufoff) + ldsw + _i * 8192), 16, 0, 0); } while (0)
#define PG8_LDA(dst, b, h) do { _Pragma("unroll") for (int m = 0; m < 4; ++m) _Pragma("unroll") for (int k = 0; k < 2; ++k) dst[m][k] = *(const LAS bf16x8*)(lds + PG8_SA(b, h) + aoff + m * 2048 + k * 1024); } while (0)
#define PG8_LDB(dst, b, h) do { _Pragma("unroll") for (int n = 0; n < 2; ++n) _Pragma("unroll") for (int k = 0; k < 2; ++k) dst[n][k] = *(const LAS bf16x8*)(lds + PG8_SB(b, h) + boff + n * 2048 + k * 1024); } while (0)
#define PG8_MMA(ai, bj, At, Bt) do { __builtin_amdgcn_s_setprio(1); _Pragma("unroll") for (int m = 0; m < 4; ++m) _Pragma("unroll") for (int n = 0; n < 2; ++n) _Pragma("unroll") for (int k = 0; k < 2; ++k) \
        acc[ai][bj][m][n] = __builtin_amdgcn_mfma_f32_16x16x32_bf16(Bt[n][k], At[m][k], acc[ai][bj][m][n], 0, 0, 0); __builtin_amdgcn_s_setprio(0); } while (0)
#define PG8_WAIT_V(n) asm volatile("s_waitcnt vmcnt(" #n ")" ::: "memory")
#define PG8_WAIT_L(n) asm volatile("s_waitcnt lgkmcnt(" #n ")" ::: "memory")
#define PG8_BAR __builtin_amdgcn_s_barrier()
#define PG8_SCHED __builtin_amdgcn_sched_barrier(0)
    Unit cur, nxt; int ui = 0;
    if (!S.next(0, cur)) return;
    f32x4 acc[2][2][4][2];
#pragma unroll
    for (int a = 0; a < 2; ++a)
#pragma unroll
        for (int b = 0; b < 2; ++b)
#pragma unroll
            for (int m = 0; m < 4; ++m)
#pragma unroll
                for (int n = 0; n < 2; ++n) acc[a][b][m][n] = (f32x4){0.f, 0.f, 0.f, 0.f};
    bf16x8 At[4][2], B0[2][2], B1[2][2];
    const char* cA = (const char*)g.A + (size_t)cur.pm * tstepA; const char* cB = (const char*)g.Bt + (size_t)cur.pn * tstepB;
    S.a_ready(cur);
    if constexpr (SP2) {
        PG8_STAGE(PG8_SB(0, 0), cB, voffB); PG8_STAGE(PG8_SB(0, 1), cB + hstepB, voffB); PG8_STAGE(PG8_SA(0, 0), cA, voffA); PG8_STAGE(PG8_SA(0, 1), cA + hstepA, voffA);
        if (wr == 1) PG8_BAR;
        PG8_WAIT_V(2); PG8_BAR;
        PG8_STAGE(PG8_SB(1, 0), cB + kstep, voffB); PG8_STAGE(PG8_SA(1, 0), cA + kstep, voffA); PG8_STAGE(PG8_SB(1, 1), cB + hstepB + kstep, voffB);
        PG8_WAIT_V(6); PG8_BAR;
    } else {
        PG8_STAGE(PG8_SB(0, 0), cB, voffB); PG8_STAGE(PG8_SA(0, 0), cA, voffA); PG8_STAGE(PG8_SB(0, 1), cB + hstepB, voffB); PG8_STAGE(PG8_SA(0, 1), cA + hstepA, voffA);
        if (wr == 1) PG8_BAR;
        PG8_WAIT_V(4); PG8_BAR;
        PG8_STAGE(PG8_SB(1, 0), cB + kstep, voffB); PG8_STAGE(PG8_SA(1, 0), cA + kstep, voffA); PG8_STAGE(PG8_SB(1, 1), cB + hstepB + kstep, voffB);
        PG8_WAIT_V(6); PG8_BAR;
    }
    for (;;) {
        const bool has_next = S.next(ui + 1, nxt);
        const char* nA = has_next ? (const char*)g.A + (size_t)nxt.pm * tstepA : cA; const char* nB = has_next ? (const char*)g.Bt + (size_t)nxt.pn * tstepB : cB;
        for (int t = 0; t < nt; t += 2) {
            const bool last = (t == nt - 2);
            const char* a1 = cA + (size_t)(t + 1) * kstep;
            const char* a2 = last ? nA : cA + (size_t)(t + 2) * kstep; const char* b2 = last ? nB : cB + (size_t)(t + 2) * kstep;
            const char* a3 = a2 + kstep; const char* b3 = b2 + kstep;
            if (last && has_next) S.a_ready(nxt);
            if constexpr (SP2) {
            PG8_LDB(B0, 0, 0); PG8_LDB(B1, 0, 1); PG8_SCHED; PG8_LDA(At, 0, 0); PG8_STAGE(PG8_SA(1, 1), a1 + hstepA, voffA);
            PG8_WAIT_V(8); PG8_WAIT_L(0); PG8_BAR; PG8_MMA(0, 0, At, B0); PG8_MMA(0, 1, At, B1); PG8_BAR; PG8_SCHED;
            PG8_LDA(At, 0, 1); PG8_STAGE(PG8_SB(0, 0), b2, voffB); PG8_STAGE(PG8_SB(0, 1), b2 + hstepB, voffB); PG8_STAGE(PG8_SA(0, 0), a2, voffA);
            PG8_WAIT_V(8); PG8_WAIT_L(0); PG8_BAR; PG8_MMA(1, 0, At, B0); PG8_MMA(1, 1, At, B1); PG8_BAR; PG8_SCHED;
            PG8_LDB(B0, 1, 0); PG8_LDB(B1, 1, 1); PG8_SCHED; PG8_LDA(At, 1, 0); PG8_STAGE(PG8_SA(0, 1), a2 + hstepA, voffA);
            PG8_WAIT_V(8); PG8_WAIT_L(0); PG8_BAR; PG8_MMA(0, 0, At, B0); PG8_MMA(0, 1, At, B1); PG8_BAR; PG8_SCHED;
            PG8_LDA(At, 1, 1); PG8_STAGE(PG8_SB(1, 0), b3, voffB); PG8_STAGE(PG8_SB(1, 1), b3 + hstepB, voffB); PG8_STAGE(PG8_SA(1, 0), a3, voffA);
            PG8_WAIT_V(8); PG8_WAIT_L(0); PG8_BAR; PG8_MMA(1, 0, At, B0); PG8_MMA(1, 1, At, B1); PG8_BAR; PG8_SCHED;
            } else {
            PG8_LDB(B0, 0, 0); PG8_SCHED; PG8_LDA(At, 0, 0); PG8_STAGE(PG8_SA(1, 1), a1 + hstepA, voffA);
            PG8_WAIT_L(8); PG8_BAR; PG8_WAIT_L(0); PG8_MMA(0, 0, At, B0); PG8_BAR; PG8_SCHED;
            PG8_LDB(B1, 0, 1); PG8_STAGE(PG8_SB(0, 0), b2, voffB);
            PG8_BAR; PG8_WAIT_L(0); PG8_MMA(0, 1, At, B1); PG8_BAR;
            PG8_LDA(At, 0, 1); PG8_STAGE(PG8_SA(0, 0), a2, voffA);
            PG8_BAR; PG8_WAIT_L(0); PG8_MMA(1, 0, At, B0); PG8_BAR; PG8_SCHED;
            PG8_STAGE(PG8_SB(0, 1), b2 + hstepB, voffB);
            PG8_WAIT_V(6); PG8_BAR; PG8_MMA(1, 1, At, B1); PG8_BAR;
            PG8_LDB(B0, 1, 0); PG8_SCHED; PG8_LDA(At, 1, 0); PG8_STAGE(PG8_SA(0, 1), a2 + hstepA, voffA);
            PG8_WAIT_L(8); PG8_BAR; PG8_WAIT_L(0); PG8_MMA(0, 0, At, B0); PG8_BAR; PG8_SCHED;
            PG8_LDB(B1, 1, 1); PG8_STAGE(PG8_SB(1, 0), b3, voffB);
            PG8_BAR; PG8_WAIT_L(0); PG8_MMA(0, 1, At, B1); PG8_BAR;
            PG8_LDA(At, 1, 1); PG8_STAGE(PG8_SA(1, 0), a3, voffA);
            PG8_BAR; PG8_WAIT_L(0); PG8_MMA(1, 0, At, B0); PG8_BAR; PG8_SCHED;
            PG8_STAGE(PG8_SB(1, 1), b3 + hstepB, voffB);
            PG8_WAIT_V(6); PG8_BAR; PG8_MMA(1, 1, At, B1); PG8_BAR;
            }
        }
        if constexpr (ALIGN_EPI) { if (wr == 0) PG8_BAR; }
        E(acc, cur, wr, wc, fr, fq);
        if (!has_next) break;
#pragma unroll
        for (int a = 0; a < 2; ++a)
#pragma unroll
            for (int b = 0; b < 2; ++b)
#pragma unroll
                for (int m = 0; m < 4; ++m)
#pragma unroll
                    for (int n = 0; n < 2; ++n) acc[a][b][m][n] = (f32x4){0.f, 0.f, 0.f, 0.f};
        cur = nxt; cA = nA; cB = nB; ++ui;
        if constexpr (ALIGN_EPI) { if (wr == 1) PG8_BAR; }
    }
    PG8_WAIT_V(0);
    if constexpr (!ALIGN_EPI) { if (wr == 0) PG8_BAR; }
    PG8_BAR;
#undef PG8_SA
#undef PG8_SB
#undef PG8_STAGE
#undef PG8_LDA
#undef PG8_LDB
#undef PG8_MMA
#undef PG8_WAIT_V
#undef PG8_WAIT_L
#undef PG8_BAR
#undef PG8_SCHED
}
}
using pg8::Unit; using pg8::Gemm; using pg8::cvt_pk_bf16;

__device__ __forceinline__ u32x4 pack8(const f32x4 a, const f32x4 b) { u32x4 w; w.x = cvt_pk_bf16(a[0], a[1]); w.y = cvt_pk_bf16(a[2], a[3]); w.z = cvt_pk_bf16(b[0], b[1]); w.w = cvt_pk_bf16(b[2], b[3]); return w; }
__device__ __forceinline__ void unpack8(const u32x4 w, f32x4& a, f32x4& b) { a = (f32x4){lo_bf(w.x), hi_bf(w.x), lo_bf(w.y), hi_bf(w.y)}; b = (f32x4){lo_bf(w.z), hi_bf(w.z), lo_bf(w.w), hi_bf(w.w)}; }
__device__ __forceinline__ f32x4 sig4(f32x4 x) { return (f32x4){sigmoidf_(x[0]), sigmoidf_(x[1]), sigmoidf_(x[2]), sigmoidf_(x[3])}; }

struct EpiRoute {
    static constexpr bool PERM = true;
    bf16_t* p0; long seg_stride; bf16_t* plast; int ld0, ldlast, tps, lastseg; float scale; int pad;
    __device__ __forceinline__ void operator()(const f32x4 (&acc)[2][2][4][2], const Unit& u, int wr, int wc, int fr, int fq) const {
        const int seg = u.pn / tps, colt = (u.pn - seg * tps) * 256; const bool lastp = seg >= lastseg;
        bf16_t* base = lastp ? plast : p0 + (long)seg * seg_stride; const int ldc = lastp ? ldlast : ld0;
        const int row0 = u.pm * 256 + wr * 64 + fr, col0 = colt + wc * 32 + 8 * fq;
#pragma unroll
        for (int ai = 0; ai < 2; ++ai)
#pragma unroll
            for (int m = 0; m < 4; ++m) { bf16_t* rowp = base + (size_t)(row0 + ai * 128 + m * 16) * ldc + col0;
#pragma unroll
                for (int bj = 0; bj < 2; ++bj) *(u32x4*)(rowp + bj * 128) = pack8(acc[ai][bj][m][0] * scale, acc[ai][bj][m][1] * scale); }
    }
};
struct EpiQ {
    static constexpr bool PERM = true;
    bf16_t* qn; bf16_t* qr; const float* rope; float qscale; int pad;
    __device__ __forceinline__ void operator()(const f32x4 (&acc)[2][2][4][2], const Unit& u, int wr, int wc, int fr, int fq) const {
        const int row0 = u.pm * 256 + wr * 64 + fr;
        if (u.pn < 4) {
            const int col0 = u.pn * 256 + wc * 32 + 8 * fq;
#pragma unroll
            for (int ai = 0; ai < 2; ++ai)
#pragma unroll
                for (int m = 0; m < 4; ++m) { bf16_t* rowp = qn + (size_t)(row0 + ai * 128 + m * 16) * 1024 + col0;
#pragma unroll
                    for (int bj = 0; bj < 2; ++bj) *(u32x4*)(rowp + bj * 128) = pack8(acc[ai][bj][m][0] * qscale, acc[ai][bj][m][1] * qscale); }
        } else {
            const int h = (u.pn - 4) * 4 + wc, i0 = 8 * fq;
#pragma unroll
            for (int ai = 0; ai < 2; ++ai)
#pragma unroll
                for (int m = 0; m < 4; ++m) { const int row = row0 + ai * 128 + m * 16; const float* rp = rope + (size_t)row * 64 + i0;
                    const f32x4 c0 = *(const f32x4*)(rp), c1 = *(const f32x4*)(rp + 4), s0 = *(const f32x4*)(rp + 32), s1 = *(const f32x4*)(rp + 36);
                    const f32x4 x10 = acc[ai][0][m][0], x11 = acc[ai][0][m][1], x20 = acc[ai][1][m][0], x21 = acc[ai][1][m][1];
                    bf16_t* op = qr + (size_t)row * 512 + h * 64 + i0;
                    *(u32x4*)(op) = pack8((x10 * c0 - x20 * s0) * qscale, (x11 * c1 - x21 * s1) * qscale);
                    *(u32x4*)(op + 32) = pack8((x10 * s0 + x20 * c0) * qscale, (x11 * s1 + x21 * c1) * qscale); }
        }
    }
};
template <int MODE> struct EpiEw {
    static constexpr bool PERM = true;
    bf16_t* O; const bf16_t* X;
    __device__ __forceinline__ void operator()(const f32x4 (&acc)[2][2][4][2], const Unit& u, int wr, int wc, int fr, int fq) const {
        const int row0 = u.pm * 256 + wr * 64 + fr, col0 = u.pn * 256 + wc * 32 + 8 * fq;
#pragma unroll
        for (int ai = 0; ai < 2; ++ai)
#pragma unroll
            for (int m = 0; m < 4; ++m) { const size_t off = (size_t)(row0 + ai * 128 + m * 16) * 1024 + col0;
#pragma unroll
                for (int bj = 0; bj < 2; ++bj) { f32x4 a = acc[ai][bj][m][0], b = acc[ai][bj][m][1];
                    if (MODE == 0) { a = sig4(a); b = sig4(b); }
                    if (MODE == 1) { f32x4 oa, ob; unpack8(*(const u32x4*)(O + off + bj * 128), oa, ob); a = oa * a * sig4(a); b = ob * b * sig4(b); }
                    if (MODE == 2) { f32x4 xa, xb; unpack8(*(const u32x4*)(X + off + bj * 128), xa, xb); a = xa * a; b = xb * b; }
                    if (MODE == 3) { f32x4 xa, xb, oa, ob; unpack8(*(const u32x4*)(X + off + bj * 128), xa, xb); unpack8(*(const u32x4*)(O + off + bj * 128), oa, ob); a = oa + xa * a; b = ob + xb * b; }
                    *(u32x4*)(O + off + bj * 128) = pack8(a, b); } }
    }
};
struct EpiSwiglu {
    static constexpr bool PERM = true;
    bf16_t* Hh;
    __device__ __forceinline__ void operator()(const f32x4 (&acc)[2][2][4][2], const Unit& u, int wr, int wc, int fr, int fq) const {
        const int row0 = u.pm * 256 + wr * 64 + fr, col0 = u.pn * 128 + wc * 32 + 8 * fq;
#pragma unroll
        for (int ai = 0; ai < 2; ++ai)
#pragma unroll
            for (int m = 0; m < 4; ++m) { const f32x4 g0 = acc[ai][0][m][0], g1 = acc[ai][0][m][1];
                *(u32x4*)(Hh + (size_t)(row0 + ai * 128 + m * 16) * 2816 + col0) = pack8(g0 * sig4(g0) * acc[ai][1][m][0], g1 * sig4(g1) * acc[ai][1][m][1]); }
    }
};

template <class Epi> __global__ __launch_bounds__(512, 2) void k_gemm(Gemm g, Epi E) {
    extern __shared__ __attribute__((aligned(16))) unsigned char shm[];
    pg8::StaticOrder S; S.init(g.M, g.N, (int)gridDim.x, (int)blockIdx.x);
    pg8::gemm_phase<Epi, pg8::StaticOrder, true, true>((LAS unsigned char*)shm, g, S, E);
}

constexpr size_t MiB = 1u << 20, U64 = 64 * MiB;
constexpr size_t WS_CTL = 0, WS_ROPE = 1 * MiB, WS_W = 10 * MiB;
constexpr size_t WS_H = 1 * U64, WS_VF = 2 * U64, WS_MG = 3 * U64, WS_XR = 4 * U64, WS_ZA = 5 * U64, WS_END = 8 * U64;
constexpr size_t KE = 1024;
constexpr size_t W_RW = 0, W_HG = W_RW + 3584 * KE, W_OG = W_HG + 3072 * KE, W_MLA = W_OG + 1024 * KE, W_GATE = W_MLA + 768 * KE, W_UQ = W_GATE + 3072 * KE,
                 W_UKV = W_UQ + 1536 * 384, W_BR = W_UKV + 2048 * 256, W_OUT = W_BR + 3072 * KE, W_FI = W_OUT + 1024 * KE, W_FO = W_FI + 5632 * KE, W_TOTAL = W_FO + 1024 * 2816;
static_assert(WS_W + W_TOTAL * 2 <= U64, "weights fit region 0");

struct Params { const float* in[32]; float* out; unsigned char* ws; };

__device__ __forceinline__ int wmap(int mapid, int n0) {
    switch (mapid) {
        case 1: { const int tile = n0 >> 8, bj = (n0 & 255) >> 7, hl = (n0 & 127) >> 5; return (tile * 4 + hl) * 192 + 128 + bj * 32; }
        case 2: return (n0 >> 7) * 192 + (n0 & 127);
        case 3: return (n0 >> 7) * 256 + (n0 & 127);
        case 4: return (n0 >> 7) * 256 + 128 + (n0 & 127);
        case 5: { const int pn = n0 >> 8, bj = (n0 & 255) >> 7, j = n0 & 127; return bj * 2816 + 128 * pn + j; }
        default: return n0;
    }
}
__device__ __forceinline__ void transpose_item(const float* W, int ld, int K, int col0, int mapid, bf16_t* WT, LAS float* scr, int item, int nblk, int lane) {
    const int kb = item / nblk, nb = item % nblk, k0 = 64 * kb, n0 = 32 * nb;
    if (W) { const int sc = col0 + wmap(mapid, n0);
#pragma unroll 8
        for (int i = 0; i < 32; ++i) { const int kk = 2 * i + (lane >> 5); scr[kk * 33 + (lane & 31)] = W[(size_t)(k0 + kk) * ld + sc + (lane & 31)]; }
    } else {
#pragma unroll 8
        for (int i = 0; i < 32; ++i) { const int kk = 2 * i + (lane >> 5); scr[kk * 33 + (lane & 31)] = 0.f; }
    }
    asm volatile("s_waitcnt vmcnt(0) lgkmcnt(0)" ::: "memory");
    const int c = lane & 7;
#pragma unroll
    for (int j = 0; j < 4; ++j) { const int n = (lane >> 3) + 8 * j; const LAS float* s = scr + (8 * c) * 33 + n;
        u32x4 o; o.x = pk2(s[0 * 33], s[1 * 33]); o.y = pk2(s[2 * 33], s[3 * 33]); o.z = pk2(s[4 * 33], s[5 * 33]); o.w = pk2(s[6 * 33], s[7 * 33]);
        *(u32x4*)(WT + (size_t)(n0 + n) * K + k0 + 8 * c) = o; }
    asm volatile("s_waitcnt lgkmcnt(0)" ::: "memory");
}
__device__ __forceinline__ void wjob(const float* src, int ld, int col0, int K, int nrows, int mapid, bf16_t* dst, LAS float* scr, int gw, int ngw, int lane) {
    const int nblk = nrows / 32, nitems = (K / 64) * nblk;
    for (int it = gw; it < nitems; it += ngw) transpose_item(src, ld, K, col0, mapid, dst, scr, it, nblk, lane);
}
__device__ __forceinline__ void phase_weights(const Params& p, int l, LAS unsigned char* lds) {
    const int wave = threadIdx.x >> 6, lane = threadIdx.x & 63, gw = blockIdx.x * (blockDim.x >> 6) + wave, ngw = gridDim.x * (blockDim.x >> 6);
    LAS float* scr = (LAS float*)(lds + wave * 8704);
    bf16_t* WB = (bf16_t*)(p.ws + WS_W);
    const float* w_in = p.in[7] + (size_t)l * 1024 * IN_W;
    wjob(w_in, IN_W, 4096, 1024, 3328, 0, WB + W_RW, scr, gw, ngw, lane);
    wjob(l == 1 ? p.in[8] : nullptr, 32, 0, 1024, 32, 0, WB + W_RW + 3328 * KE, scr, gw, ngw, lane);
    wjob(nullptr, 0, 0, 1024, 224, 0, WB + W_RW + 3360 * KE, scr, gw, ngw, lane);
    wjob(w_in, IN_W, 0, 1024, 3072, 0, WB + W_HG, scr, gw, ngw, lane);
    wjob(w_in, IN_W, 3072, 1024, 1024, 0, WB + W_OG, scr, gw, ngw, lane);
    wjob(w_in, IN_W, 7424, 1024, 704, 0, WB + W_MLA, scr, gw, ngw, lane);
    wjob(nullptr, 0, 0, 1024, 64, 0, WB + W_MLA + 704 * KE, scr, gw, ngw, lane);
    wjob(w_in, IN_W, 8128, 1024, 3072, 0, WB + W_GATE, scr, gw, ngw, lane);
    const float* wuq = p.in[25] + (size_t)l * 384 * 1536;
    wjob(wuq, 1536, 0, 384, 1024, 2, WB + W_UQ, scr, gw, ngw, lane);
    wjob(wuq, 1536, 0, 384, 512, 1, WB + W_UQ + 1024 * 384, scr, gw, ngw, lane);
    const float* wukv = p.in[27] + (size_t)l * 256 * 2048;
    wjob(wukv, 2048, 0, 256, 1024, 3, WB + W_UKV, scr, gw, ngw, lane);
    wjob(wukv, 2048, 0, 256, 1024, 4, WB + W_UKV + 1024 * 256, scr, gw, ngw, lane);
    for (int b = 0; b < 3; ++b) wjob(p.in[28] + ((size_t)l * 3 + b) * KE * KE, 1024, 0, 1024, 1024, 0, WB + W_BR + b * KE * KE, scr, gw, ngw, lane);
    wjob(p.in[29] + (size_t)l * KE * KE, 1024, 0, 1024, 1024, 0, WB + W_OUT, scr, gw, ngw, lane);
    wjob(p.in[30] + (size_t)l * 1024 * 5632, 5632, 0, 1024, 5632, 5, WB + W_FI, scr, gw, ngw, lane);
    wjob(p.in[31] + (size_t)l * 2816 * 1024, 1024, 0, 2816, 1024, 0, WB + W_FO, scr, gw, ngw, lane);
}
__global__ __launch_bounds__(512, 2) void k_weights(Params p, int l) {
    extern __shared__ __attribute__((aligned(16))) unsigned char shm[];
    phase_weights(p, l, (LAS unsigned char*)shm);
}

__global__ void k_rope(Params p) {
    const int idx = blockIdx.x * blockDim.x + threadIdx.x; if (idx >= T * 32) return;
    const int row = idx >> 5, i = idx & 31;
    const float inv = powf(10000.0f, -(float)(2 * i) / 64.0f);
    const float ang = (float)((const int*)p.in[1])[row] * inv;
    float s, c; sincosf(ang, &s, &c);
    float* rope = (float*)(p.ws + WS_ROPE);
    rope[(size_t)row * 64 + i] = c; rope[(size_t)row * 64 + 32 + i] = s;
}

__device__ __forceinline__ void load_row_f32(const float* r, int lane, f32x4 (&v)[4]) {
#pragma unroll
    for (int j = 0; j < 4; ++j) v[j] = *(const f32x4*)(r + 4 * lane + 256 * j);
}
__device__ __forceinline__ void load_row_bf16(const bf16_t* r, int lane, f32x4 (&v)[4]) {
#pragma unroll
    for (int j = 0; j < 4; ++j) { const u32x2 w = *(const u32x2*)(r + 4 * lane + 256 * j); v[j] = (f32x4){lo_bf(w.x), hi_bf(w.x), lo_bf(w.y), hi_bf(w.y)}; }
}
__device__ __forceinline__ void store_row_bf16(bf16_t* r, int lane, const f32x4 (&v)[4]) {
#pragma unroll
    for (int j = 0; j < 4; ++j) { u32x2 w; w.x = pk2(v[j][0], v[j][1]); w.y = pk2(v[j][2], v[j][3]); *(u32x2*)(r + 4 * lane + 256 * j) = w; }
}
__device__ __forceinline__ float row_rstd(const f32x4 (&v)[4]) {
    float s = 0.f;
#pragma unroll
    for (int j = 0; j < 4; ++j) s += (v[j][0] * v[j][0] + v[j][1] * v[j][1]) + (v[j][2] * v[j][2] + v[j][3] * v[j][3]);
    return rsqrtf(wave_sum(s) * (1.0f / 1024.0f) + NORM_EPS);
}
__global__ void k_norm0(const float* x, const float* g, bf16_t* h) {
    const int lane = threadIdx.x & 63, row = blockIdx.x * (blockDim.x >> 6) + (threadIdx.x >> 6); if (row >= T) return;
    f32x4 v[4], gg[4]; load_row_f32(x + (size_t)row * D, lane, v); load_row_f32(g, lane, gg);
    const float rs = row_rstd(v);
#pragma unroll
    for (int j = 0; j < 4; ++j) v[j] = v[j] * rs * gg[j];
    store_row_bf16(h + (size_t)row * D, lane, v);
}
__global__ void k_normres(const bf16_t* y, const float* xo_f32, const bf16_t* xo_bf, const float* gpost, bf16_t* xr_out, float* xf_out, const float* gnext, bf16_t* h) {
    const int lane = threadIdx.x & 63, row = blockIdx.x * (blockDim.x >> 6) + (threadIdx.x >> 6); if (row >= T) return;
    f32x4 v[4], xo[4], gg[4]; load_row_bf16(y + (size_t)row * D, lane, v); load_row_f32(gpost, lane, gg);
    if (xo_f32) load_row_f32(xo_f32 + (size_t)row * D, lane, xo); else load_row_bf16(xo_bf + (size_t)row * D, lane, xo);
    const float rs = row_rstd(v);
#pragma unroll
    for (int j = 0; j < 4; ++j) v[j] = xo[j] + v[j] * rs * gg[j];
    if (xf_out) {
#pragma unroll
        for (int j = 0; j < 4; ++j) *(f32x4*)(xf_out + (size_t)row * D + 4 * lane + 256 * j) = v[j];
    } else store_row_bf16(xr_out + (size_t)row * D, lane, v);
    if (gnext) { load_row_f32(gnext, lane, gg); const float rs2 = row_rstd(v);
#pragma unroll
        for (int j = 0; j < 4; ++j) v[j] = v[j] * rs2 * gg[j];
        store_row_bf16(h + (size_t)row * D, lane, v); }
}

__global__ void k_mla_prep(bf16_t* zmla, const float* gq, const float* gkv, const float* rope, bf16_t* krope) {
    const int lane = threadIdx.x & 63, row = blockIdx.x * (blockDim.x >> 6) + (threadIdx.x >> 6); if (row >= T) return;
    bf16_t* z = zmla + (size_t)row * 768;
    float q[6]; float s = 0.f;
#pragma unroll
    for (int j = 0; j < 6; ++j) { q[j] = bf2f(z[lane + 64 * j]); s += q[j] * q[j]; }
    const float rq = rsqrtf(wave_sum(s) * (1.0f / 384.0f) + NORM_EPS);
#pragma unroll
    for (int j = 0; j < 6; ++j) z[lane + 64 * j] = (bf16_t)f2bf(q[j] * rq * gq[lane + 64 * j]);
    float c[4]; s = 0.f;
#pragma unroll
    for (int j = 0; j < 4; ++j) { c[j] = bf2f(z[384 + lane + 64 * j]); s += c[j] * c[j]; }
    const float rc = rsqrtf(wave_sum(s) * (1.0f / 256.0f) + NORM_EPS);
#pragma unroll
    for (int j = 0; j < 4; ++j) z[384 + lane + 64 * j] = (bf16_t)f2bf(c[j] * rc * gkv[lane + 64 * j]);
    if (lane < 32) { const float x1 = bf2f(z[640 + lane]), x2 = bf2f(z[672 + lane]); const float cs = rope[(size_t)row * 64 + lane], sn = rope[(size_t)row * 64 + 32 + lane];
        krope[(size_t)row * 64 + lane] = (bf16_t)f2bf(x1 * cs - x2 * sn); krope[(size_t)row * 64 + 32 + lane] = (bf16_t)f2bf(x1 * sn + x2 * cs); }
}

__global__ __launch_bounds__(256) void k_attn_slow(bf16_t* qn, const bf16_t* qr, const bf16_t* kn, const bf16_t* krope, const bf16_t* vv) {
    const int bh = blockIdx.x >> 4, qb = blockIdx.x & 15, b = bh >> 3, h = bh & 7;
    const int t = qb * 256 + threadIdx.x; const size_t row = (size_t)b * SEQ + t;
    unsigned qp[96];
#pragma unroll
    for (int i = 0; i < 64; ++i) qp[i] = ((const unsigned*)(qn + row * 1024 + h * 128))[i];
#pragma unroll
    for (int i = 0; i < 32; ++i) qp[64 + i] = ((const unsigned*)(qr + row * 512 + h * 64))[i];
    float o[128];
#pragma unroll
    for (int i = 0; i < 128; ++i) o[i] = 0.f;
    float mx = -1e30f, l = 0.f;
    const int jend = qb * 256 + 256;
    for (int j = 0; j < jend; ++j) {
        const size_t kr = (size_t)b * SEQ + j;
        const unsigned* kp = (const unsigned*)(kn + kr * 1024 + h * 128); const unsigned* krp = (const unsigned*)(krope + kr * 64); const unsigned* vp = (const unsigned*)(vv + kr * 1024 + h * 128);
        float s = 0.f;
#pragma unroll
        for (int i = 0; i < 64; ++i) { const unsigned kw = kp[i]; s += lo_bf(qp[i]) * lo_bf(kw) + hi_bf(qp[i]) * hi_bf(kw); }
#pragma unroll
        for (int i = 0; i < 32; ++i) { const unsigned kw = krp[i]; s += lo_bf(qp[64 + i]) * lo_bf(kw) + hi_bf(qp[64 + i]) * hi_bf(kw); }
        if (j <= t) {
            const float mn = fmaxf(mx, s), al = exp2f(mx - mn), pr = exp2f(s - mn);
            l = l * al + pr; mx = mn;
#pragma unroll
            for (int i = 0; i < 64; ++i) { const unsigned vw = vp[i]; o[2 * i] = o[2 * i] * al + pr * lo_bf(vw); o[2 * i + 1] = o[2 * i + 1] * al + pr * hi_bf(vw); }
        }
    }
    const float inv = 1.0f / l;
    unsigned* op = (unsigned*)(qn + row * 1024 + h * 128);
#pragma unroll
    for (int i = 0; i < 64; ++i) op[i] = pk2(o[2 * i] * inv, o[2 * i + 1] * inv);
}

namespace att {
typedef float f32x16 __attribute__((ext_vector_type(16)));
typedef short s16x4 __attribute__((ext_vector_type(4)));
constexpr int KSTR = 400, VSTR = 320, KBUF = 64 * KSTR, VBUF = 64 * VSTR, LDS_BYTES = 2 * KBUF + 2 * VBUF;
__device__ __forceinline__ int crow(int r, int hi) { return (r & 3) + 8 * (r >> 2) + 4 * hi; }
template <int OFF> __device__ __forceinline__ s16x4 tr_read(unsigned vb) { s16x4 r; asm volatile("ds_read_b64_tr_b16 %0, %1 offset:%2" : "=&v"(r) : "v"(vb), "i"(OFF) : "memory"); return r; }
__device__ __forceinline__ float swap_max(float x) { auto rr = __builtin_amdgcn_permlane32_swap(__float_as_uint(x), __float_as_uint(x), false, false); return fmaxf(__uint_as_float(rr[0]), __uint_as_float(rr[1])); }
__device__ __forceinline__ float swap_sum(float x) { auto rr = __builtin_amdgcn_permlane32_swap(__float_as_uint(x), __float_as_uint(x), false, false); return __uint_as_float(rr[0]) + __uint_as_float(rr[1]); }
template <int D0> __device__ __forceinline__ void pv_one(f32x16& od, unsigned vb, const bf16x8 (&pb)[4]) {
    const s16x4 l0 = tr_read<(0 * 16) * VSTR + 64 * D0>(vb), h0 = tr_read<(0 * 16 + 8) * VSTR + 64 * D0>(vb), l1 = tr_read<(1 * 16) * VSTR + 64 * D0>(vb), h1 = tr_read<(1 * 16 + 8) * VSTR + 64 * D0>(vb);
    const s16x4 l2 = tr_read<(2 * 16) * VSTR + 64 * D0>(vb), h2 = tr_read<(2 * 16 + 8) * VSTR + 64 * D0>(vb), l3 = tr_read<(3 * 16) * VSTR + 64 * D0>(vb), h3 = tr_read<(3 * 16 + 8) * VSTR + 64 * D0>(vb);
    asm volatile("s_waitcnt lgkmcnt(0)" ::: "memory"); __builtin_amdgcn_sched_barrier(0);
#define ATT_PK(L, H) (bf16x8){L[0], L[1], L[2], L[3], H[0], H[1], H[2], H[3]}
    od = __builtin_amdgcn_mfma_f32_32x32x16_bf16(ATT_PK(l0, h0), pb[0], od, 0, 0, 0);
    od = __builtin_amdgcn_mfma_f32_32x32x16_bf16(ATT_PK(l1, h1), pb[1], od, 0, 0, 0);
    od = __builtin_amdgcn_mfma_f32_32x32x16_bf16(ATT_PK(l2, h2), pb[2], od, 0, 0, 0);
    od = __builtin_amdgcn_mfma_f32_32x32x16_bf16(ATT_PK(l3, h3), pb[3], od, 0, 0, 0);
#undef ATT_PK
}
__device__ __forceinline__ void attn_unit(int b, int h, int qb, bf16_t* qn, const bf16_t* qr, const bf16_t* kn, const bf16_t* krope, const bf16_t* vv, LAS unsigned char* lds) {
    const int tid = threadIdx.x, wid = __builtin_amdgcn_readfirstlane(tid >> 6), lane = tid & 63, c = lane & 31, hh = lane >> 5;
    const size_t row0 = (size_t)b * SEQ;
    const int qrow = qb * 256 + wid * 32 + c;
    bf16x8 qf[12];
    { const bf16_t* q1 = qn + (row0 + qrow) * 1024 + h * 128 + 8 * hh; const bf16_t* q2 = qr + (row0 + qrow) * 512 + h * 64 + 8 * hh;
#pragma unroll
      for (int s = 0; s < 8; ++s) qf[s] = *(const bf16x8*)(q1 + 16 * s);
#pragma unroll
      for (int s = 0; s < 4; ++s) qf[8 + s] = *(const bf16x8*)(q2 + 16 * s); }
    f32x16 o[4];
#pragma unroll
    for (int d = 0; d < 4; ++d)
#pragma unroll
        for (int r = 0; r < 16; ++r) o[d][r] = 0.f;
    float m_run = -1e30f, l_run = 0.f;
    const int r_a = tid >> 4, ch_a = tid & 15;
    const int r_k = tid >> 3, ch_k = tid & 7;
    const bf16_t* gkn = kn + (row0 + r_a) * 1024 + h * 128 + ch_a * 8; const bf16_t* gv = vv + (row0 + r_a) * 1024 + h * 128 + ch_a * 8; const bf16_t* gkr = krope + (row0 + r_k) * 64 + ch_k * 8;
    u32x4 st_k0, st_k1, st_kr, st_v0, st_v1;
#define ATT_GLOAD(j) do { const size_t ko = (size_t)(j) * 64 * 1024; st_k0 = *(const u32x4*)(gkn + ko); st_k1 = *(const u32x4*)(gkn + ko + 32 * 1024); st_v0 = *(const u32x4*)(gv + ko); st_v1 = *(const u32x4*)(gv + ko + 32 * 1024); \
        st_kr = *(const u32x4*)(gkr + (size_t)(j) * 64 * 64); } while (0)
#define ATT_SWRITE(bufi) do { LAS unsigned char* kb = lds + (bufi) * KBUF; LAS unsigned char* vb_ = lds + 2 * KBUF + (bufi) * VBUF; \
        *(LAS u32x4*)(kb + r_a * KSTR + ch_a * 16) = st_k0; *(LAS u32x4*)(kb + (r_a + 32) * KSTR + ch_a * 16) = st_k1; *(LAS u32x4*)(kb + r_k * KSTR + 256 + ch_k * 16) = st_kr; \
        *(LAS u32x4*)(vb_ + r_a * VSTR + ch_a * 16) = st_v0; *(LAS u32x4*)(vb_ + (r_a + 32) * VSTR + ch_a * 16) = st_v1; } while (0)
    const int NT = 4 * (qb + 1);
    const int qlo = qb * 256 + wid * 32;
    const unsigned vrd = (unsigned)((4 * (lane >> 5) + ((lane & 15) >> 2)) * VSTR + (16 * ((lane >> 4) & 1) + 4 * (lane & 3)) * 2);
    const unsigned krd = (unsigned)(c * KSTR + 16 * hh);
    __syncthreads();
    ATT_GLOAD(0); ATT_SWRITE(0); __syncthreads();
    for (int j = 0; j < NT; ++j) {
        if (j + 1 < NT) ATT_GLOAD(j + 1);
        if (64 * j <= qlo + 31) {
            const unsigned kbase = (unsigned)(uintptr_t)(lds + (j & 1) * KBUF) + krd;
            f32x16 p0, p1;
#pragma unroll
            for (int r = 0; r < 16; ++r) { p0[r] = 0.f; p1[r] = 0.f; }
#pragma unroll
            for (int s = 0; s < 12; ++s) {
                const bf16x8 a0 = *(const LAS bf16x8*)(uintptr_t)(kbase + 32 * s), a1 = *(const LAS bf16x8*)(uintptr_t)(kbase + 32 * KSTR + 32 * s);
                p0 = __builtin_amdgcn_mfma_f32_32x32x16_bf16(a0, qf[s], p0, 0, 0, 0);
                p1 = __builtin_amdgcn_mfma_f32_32x32x16_bf16(a1, qf[s], p1, 0, 0, 0); }
            if (64 * j + 63 > qlo) {
                const int kq = qrow - 64 * j;
#pragma unroll
                for (int r = 0; r < 16; ++r) { if (crow(r, hh) > kq) p0[r] = -__builtin_inff(); if (32 + crow(r, hh) > kq) p1[r] = -__builtin_inff(); }
            }
            float mx = p0[0];
#pragma unroll
            for (int r = 1; r < 16; ++r) mx = fmaxf(mx, p0[r]);
#pragma unroll
            for (int r = 0; r < 16; ++r) mx = fmaxf(mx, p1[r]);
            mx = swap_max(mx);
            const float mn = fmaxf(m_run, mx), alpha = __builtin_amdgcn_exp2f(m_run - mn); m_run = mn;
            float ps = 0.f;
#pragma unroll
            for (int r = 0; r < 16; ++r) { p0[r] = __builtin_amdgcn_exp2f(p0[r] - mn); p1[r] = __builtin_amdgcn_exp2f(p1[r] - mn); ps += p0[r] + p1[r]; }
            l_run = l_run * alpha + ps;
            if (!__all(alpha == 1.0f)) {
#pragma unroll
                for (int d = 0; d < 4; ++d)
#pragma unroll
                    for (int r = 0; r < 16; ++r) o[d][r] *= alpha;
            }
            bf16x8 pb[4];
#pragma unroll
            for (int s = 0; s < 2; ++s) {
                u32x4 w0, w1;
                w0.x = cvt_pk_bf16(p0[8 * s + 0], p0[8 * s + 1]); w0.y = cvt_pk_bf16(p0[8 * s + 2], p0[8 * s + 3]); w0.z = cvt_pk_bf16(p0[8 * s + 4], p0[8 * s + 5]); w0.w = cvt_pk_bf16(p0[8 * s + 6], p0[8 * s + 7]);
                w1.x = cvt_pk_bf16(p1[8 * s + 0], p1[8 * s + 1]); w1.y = cvt_pk_bf16(p1[8 * s + 2], p1[8 * s + 3]); w1.z = cvt_pk_bf16(p1[8 * s + 4], p1[8 * s + 5]); w1.w = cvt_pk_bf16(p1[8 * s + 6], p1[8 * s + 7]);
                pb[s] = __builtin_bit_cast(bf16x8, w0); pb[2 + s] = __builtin_bit_cast(bf16x8, w1); }
            const unsigned vbase = (unsigned)(uintptr_t)(lds + 2 * KBUF + (j & 1) * VBUF) + vrd;
            pv_one<0>(o[0], vbase, pb); pv_one<1>(o[1], vbase, pb); pv_one<2>(o[2], vbase, pb); pv_one<3>(o[3], vbase, pb);
        }
        if (j + 1 < NT) ATT_SWRITE((j + 1) & 1);
        __syncthreads();
    }
#undef ATT_GLOAD
#undef ATT_SWRITE
    const float inv = 1.0f / swap_sum(l_run);
    bf16_t* op = qn + (row0 + qrow) * 1024 + h * 128 + 4 * hh;
#pragma unroll
    for (int d = 0; d < 4; ++d)
#pragma unroll
        for (int g = 0; g < 4; ++g) { u32x2 w; w.x = cvt_pk_bf16(o[d][4 * g] * inv, o[d][4 * g + 1] * inv); w.y = cvt_pk_bf16(o[d][4 * g + 2] * inv, o[d][4 * g + 3] * inv);
            *(u32x2*)(op + 32 * d + 8 * g) = w; }
}
__device__ __forceinline__ void attn_phase(bf16_t* qn, const bf16_t* qr, const bf16_t* kn, const bf16_t* krope, const bf16_t* vv, LAS unsigned char* lds) {
    const int G = gridDim.x, bx = blockIdx.x, vcu = (G % 8 == 0) ? (bx % 8) * (G / 8) + bx / 8 : bx;
    for (int u = vcu; u < 512; u += G) { const int bh = u >> 3, p = u & 7;
        attn_unit(bh >> 3, bh & 7, 15 - p, qn, qr, kn, krope, vv, lds);
        attn_unit(bh >> 3, bh & 7, p, qn, qr, kn, krope, vv, lds); }
}
}
__global__ __launch_bounds__(512, 2) void k_attn(bf16_t* qn, const bf16_t* qr, const bf16_t* kn, const bf16_t* krope, const bf16_t* vv) {
    extern __shared__ __attribute__((aligned(16))) unsigned char shm[];
    att::attn_phase(qn, qr, kn, krope, vv, (LAS unsigned char*)shm);
}

__global__ void k_hgrn_prep(bf16_t* zf, bf16_t* kk, const float* lbl, int l) {
    const size_t idx = ((size_t)blockIdx.x * blockDim.x + threadIdx.x) * 2; if (idx >= (size_t)T * 1024) return;
    const int c = (int)(idx & 1023);
    const unsigned w = *(const unsigned*)(zf + idx); float r[2], k[2];
#pragma unroll
    for (int e = 0; e < 2; ++e) { const float z = e ? hi_bf(w) : lo_bf(w); float lb = 0.f;
        if (l == 1) { const float l0 = lbl[c + e], l1 = lbl[1024 + c + e]; lb = 1.0f / (1.0f + __expf(l0 - l1)); }
        const float f = lb + (1.0f - lb) * sigmoidf_(z); r[e] = __logf(fmaxf(f, 1e-30f)); k[e] = (1.0f - lb) * sigmoidf_(-z); }
    *(unsigned*)(zf + idx) = pk2(r[0], r[1]); *(unsigned*)(kk + idx) = pk2(k[0], k[1]);
}
__global__ __launch_bounds__(128) void k_hgrn_slow(const bf16_t* zq, const bf16_t* lf, const bf16_t* zi, bf16_t* ohg) {
    const int b = blockIdx.x >> 3, h = blockIdx.x & 7, v = threadIdx.x;
    __shared__ float sf[16][128], sq[16][128];
    float S[128];
#pragma unroll
    for (int k = 0; k < 128; ++k) S[k] = 0.f;
    for (int t0 = 0; t0 < SEQ; t0 += 16) {
        __syncthreads();
        for (int e = threadIdx.x; e < 16 * 128; e += 128) { const int tt = e >> 7, k = e & 127; const size_t off = ((size_t)b * SEQ + t0 + tt) * 1024 + h * 128 + k;
            sf[tt][k] = __expf(bf2f(lf[off])); sq[tt][k] = bf2f(zq[off]); }
        __syncthreads();
        for (int tt = 0; tt < 16; ++tt) {
            const size_t off = ((size_t)b * SEQ + t0 + tt) * 1024 + h * 128 + v;
            const float iv = bf2f(zi[off]); float o = 0.f;
#pragma unroll
            for (int k = 0; k < 128; ++k) { const float f = sf[tt][k]; S[k] = f * S[k] + (1.0f - f) * iv; o += sq[tt][k] * S[k]; }
            ohg[off] = (bf16_t)f2bf(o);
        }
    }
}
__global__ void k_hgrn_post(bf16_t* ohg, const float* g) {
    const int lane = threadIdx.x & 63, row = blockIdx.x * (blockDim.x >> 6) + (threadIdx.x >> 6); if (row >= T) return;
    bf16_t* o = ohg + (size_t)row * 1024;
    for (int h = 0; h < 8; ++h) { const unsigned w = *(const unsigned*)(o + h * 128 + 2 * lane); const float a = lo_bf(w), c = hi_bf(w);
        const float rs = rsqrtf(wave_sum(a * a + c * c) * (1.0f / 128.0f) + NORM_EPS);
        *(unsigned*)(o + h * 128 + 2 * lane) = pk2(a * rs * g[2 * lane], c * rs * g[2 * lane + 1]); }
}

namespace hg {
typedef float f32x16 __attribute__((ext_vector_type(16)));
typedef short s16x4 __attribute__((ext_vector_type(4)));
constexpr int TS = 320, RS = 264;
constexpr int OFF_LF = 0, OFF_Q = 32 * TS, OFF_KR = OFF_Q + 32 * RS, OFF_KT = OFF_KR + 32 * RS, OFF_I = OFF_KT + 32 * TS, RAWB = OFF_I + 32 * TS;
constexpr int PSTR = 72, OFF_P = 2 * RAWB, LDS_BYTES = OFF_P + 8 * 64 * PSTR;
__device__ __forceinline__ int crow(int r, int hi) { return (r & 3) + 8 * (r >> 2) + 4 * hi; }
__device__ __forceinline__ s16x4 trr(unsigned a) { return __builtin_amdgcn_ds_read_tr16_b64_v4i16((LAS s16x4*)(uintptr_t)a); }
__device__ __forceinline__ u32x2 rd64(unsigned a) { return *(const LAS u32x2*)(uintptr_t)a; }
#define HG_WAITL() do { } while (0)
#define HG_PK(L, H) (bf16x8){L[0], L[1], L[2], L[3], H[0], H[1], H[2], H[3]}
__device__ __forceinline__ bf16x8 cvt8(const f32x16& x, int o) { u32x4 w; w.x = cvt_pk_bf16(x[o], x[o + 1]); w.y = cvt_pk_bf16(x[o + 2], x[o + 3]); w.z = cvt_pk_bf16(x[o + 4], x[o + 5]); w.w = cvt_pk_bf16(x[o + 6], x[o + 7]); return __builtin_bit_cast(bf16x8, w); }
__device__ __forceinline__ float ex(float x) { return __builtin_amdgcn_exp2f(x * 1.4426950408889634f); }

__device__ __forceinline__ void hgrn_bh(int b, int h, const bf16_t* zq, const bf16_t* lf, const bf16_t* kk, const bf16_t* zi, bf16_t* ohg, const float* gain, LAS unsigned char* lds) {
    const int tid = threadIdx.x, wid = __builtin_amdgcn_readfirstlane(tid >> 6), lane = tid & 63, c = lane & 31, hh = lane >> 5, w = wid & 3, u = wid >> 2;
    const size_t row0 = (size_t)b * SEQ;
    const int st_t = tid >> 4, st_c = tid & 15;
    const size_t goff = (row0 + st_t) * 1024 + h * 128 + st_c * 8;
    u32x4 s_lf, s_q, s_k, s_i;
#define HG_GLOAD(ch) do { const size_t o_ = goff + (size_t)(ch) * 32 * 1024; s_lf = *(const u32x4*)(lf + o_); s_q = *(const u32x4*)(zq + o_); s_k = *(const u32x4*)(kk + o_); s_i = *(const u32x4*)(zi + o_); } while (0)
#define HG_SWRITE(bi) do { LAS unsigned char* rb = lds + (bi) * RAWB; *(LAS u32x4*)(rb + OFF_LF + st_t * TS + st_c * 16) = s_lf; *(LAS u32x4*)(rb + OFF_KT + st_t * TS + st_c * 16) = s_k; *(LAS u32x4*)(rb + OFF_I + st_t * TS + st_c * 16) = s_i; \
        *(LAS u32x2*)(rb + OFF_Q + st_t * RS + st_c * 16) = (u32x2){s_q.x, s_q.y}; *(LAS u32x2*)(rb + OFF_Q + st_t * RS + st_c * 16 + 8) = (u32x2){s_q.z, s_q.w}; \
        *(LAS u32x2*)(rb + OFF_KR + st_t * RS + st_c * 16) = (u32x2){s_k.x, s_k.y}; *(LAS u32x2*)(rb + OFF_KR + st_t * RS + st_c * 16 + 8) = (u32x2){s_k.z, s_k.w}; } while (0)
    bf16x8 Lt[2], On;
#pragma unroll
    for (int ks = 0; ks < 2; ++ks)
#pragma unroll
        for (int j = 0; j < 8; ++j) Lt[ks][j] = (short)((16 * ks + 8 * hh + j <= c) ? 0x3F80 : 0);
#pragma unroll
    for (int j = 0; j < 8; ++j) On[j] = (short)0x3F80;
    const int q_ = (lane & 15) >> 2, p_ = lane & 3, g1 = (lane >> 4) & 1;
    const unsigned trn = (unsigned)((8 * hh + q_) * TS + (16 * g1 + 4 * p_) * 2), trp = (unsigned)((4 * hh + q_) * TS + (16 * g1 + 4 * p_) * 2);
    const unsigned rrd = (unsigned)(c * RS + (32 * w + 4 * hh) * 2);
    f32x16 S0, S1;
#pragma unroll
    for (int r = 0; r < 16; ++r) { S0[r] = 0.f; S1[r] = 0.f; }
    const float g_a = gain[lane], g_b = gain[64 + lane];
    const unsigned ldsb = (unsigned)(uintptr_t)lds;
    __syncthreads();
    HG_GLOAD(0); HG_SWRITE(0); __syncthreads();
    for (int ch = 0; ch < SEQ / 32; ++ch) {
        if (ch + 1 < SEQ / 32) HG_GLOAD(ch + 1);
        const unsigned rb = ldsb + (unsigned)((ch & 1) * RAWB);
        f32x16 bT, b2, bC;
        {
            const unsigned a = rb + OFF_LF + trn + 64 * w;
            const s16x4 l0 = trr(a), h0 = trr(a + 4 * TS), l1 = trr(a + 16 * TS), h1 = trr(a + 20 * TS);
            HG_WAITL();
            const bf16x8 f0 = HG_PK(l0, h0), f1 = HG_PK(l1, h1);
            f32x16 z;
#pragma unroll
            for (int r = 0; r < 16; ++r) z[r] = 0.f;
            bT = __builtin_amdgcn_mfma_f32_32x32x16_bf16(f0, Lt[0], z, 0, 0, 0); bT = __builtin_amdgcn_mfma_f32_32x32x16_bf16(f1, Lt[1], bT, 0, 0, 0);
            bC = __builtin_amdgcn_mfma_f32_32x32x16_bf16(f0, On, z, 0, 0, 0);    bC = __builtin_amdgcn_mfma_f32_32x32x16_bf16(f1, On, bC, 0, 0, 0);
            b2 = __builtin_amdgcn_mfma_f32_32x32x16_bf16(Lt[0], f0, z, 0, 0, 0); b2 = __builtin_amdgcn_mfma_f32_32x32x16_bf16(Lt[1], f1, b2, 0, 0, 0);
        }
        bf16x8 qf[2], kf[2];
        {
            const unsigned aq = rb + OFF_Q + rrd, ak = rb + OFF_KR + rrd;
            const u32x2 q0 = rd64(aq), q1 = rd64(aq + 16), q2 = rd64(aq + 32), q3 = rd64(aq + 48), k0 = rd64(ak), k1 = rd64(ak + 16), k2 = rd64(ak + 32), k3 = rd64(ak + 48);
            HG_WAITL();
            f32x16 eb;
#pragma unroll
            for (int r = 0; r < 16; ++r) eb[r] = ex(bT[r]);
            f32x16 qv, kv;
            qv[0] = lo_bf(q0.x) * eb[0]; qv[1] = hi_bf(q0.x) * eb[1]; qv[2] = lo_bf(q0.y) * eb[2]; qv[3] = hi_bf(q0.y) * eb[3];
            qv[4] = lo_bf(q1.x) * eb[4]; qv[5] = hi_bf(q1.x) * eb[5]; qv[6] = lo_bf(q1.y) * eb[6]; qv[7] = hi_bf(q1.y) * eb[7];
            qv[8] = lo_bf(q2.x) * eb[8]; qv[9] = hi_bf(q2.x) * eb[9]; qv[10] = lo_bf(q2.y) * eb[10]; qv[11] = hi_bf(q2.y) * eb[11];
            qv[12] = lo_bf(q3.x) * eb[12]; qv[13] = hi_bf(q3.x) * eb[13]; qv[14] = lo_bf(q3.y) * eb[14]; qv[15] = hi_bf(q3.y) * eb[15];
#pragma unroll
            for (int r = 0; r < 16; ++r) eb[r] = ex(-bT[r]);
            kv[0] = lo_bf(k0.x) * eb[0]; kv[1] = hi_bf(k0.x) * eb[1]; kv[2] = lo_bf(k0.y) * eb[2]; kv[3] = hi_bf(k0.y) * eb[3];
            kv[4] = lo_bf(k1.x) * eb[4]; kv[5] = hi_bf(k1.x) * eb[5]; kv[6] = lo_bf(k1.y) * eb[6]; kv[7] = hi_bf(k1.y) * eb[7];
            kv[8] = lo_bf(k2.x) * eb[8]; kv[9] = hi_bf(k2.x) * eb[9]; kv[10] = lo_bf(k2.y) * eb[10]; kv[11] = hi_bf(k2.y) * eb[11];
            kv[12] = lo_bf(k3.x) * eb[12]; kv[13] = hi_bf(k3.x) * eb[13]; kv[14] = lo_bf(k3.y) * eb[14]; kv[15] = hi_bf(k3.y) * eb[15];
            qf[0] = cvt8(qv, 0); qf[1] = cvt8(qv, 8); kf[0] = cvt8(kv, 0); kf[1] = cvt8(kv, 8);
        }
        bf16x8 dA[2];
        {
            f32x16 dp;
#pragma unroll
            for (int r = 0; r < 16; ++r) dp[r] = 0.f;
            dp = __builtin_amdgcn_mfma_f32_32x32x16_bf16(kf[0], qf[0], dp, 0, 0, 0); dp = __builtin_amdgcn_mfma_f32_32x32x16_bf16(kf[1], qf[1], dp, 0, 0, 0);
#pragma unroll
            for (int r = 0; r < 16; ++r) if (crow(r, hh) > c) dp[r] = 0.f;
            dA[0] = cvt8(dp, 0); dA[1] = cvt8(dp, 8);
        }
        bf16x8 kT[2]; f32x16 eC;
        {
            const unsigned a = rb + OFF_KT + trp + 64 * w;
            const s16x4 l0 = trr(a), h0 = trr(a + 8 * TS), l1 = trr(a + 16 * TS), h1 = trr(a + 24 * TS);
            HG_WAITL();
            f32x16 e2;
#pragma unroll
            for (int r = 0; r < 16; ++r) { e2[r] = ex(-b2[r]); eC[r] = ex(bC[r]); }
            f32x16 kv;
#pragma unroll
            for (int j = 0; j < 4; ++j) { kv[j] = bf2f((unsigned short)l0[j]) * e2[j]; kv[4 + j] = bf2f((unsigned short)h0[j]) * e2[4 + j]; kv[8 + j] = bf2f((unsigned short)l1[j]) * e2[8 + j]; kv[12 + j] = bf2f((unsigned short)h1[j]) * e2[12 + j]; }
            kT[0] = cvt8(kv, 0); kT[1] = cvt8(kv, 8);
        }
#pragma unroll
        for (int i = 0; i < 2; ++i) {
            f32x16& S = i == 0 ? S0 : S1;
            const unsigned a = rb + OFF_I + trp + 64 * (2 * u + i);
            const s16x4 l0 = trr(a), h0 = trr(a + 8 * TS), l1 = trr(a + 16 * TS), h1 = trr(a + 24 * TS);
            HG_WAITL();
            const bf16x8 i0 = HG_PK(l0, h0), i1 = HG_PK(l1, h1);
            f32x16 o;
#pragma unroll
            for (int r = 0; r < 16; ++r) o[r] = 0.f;
            o = __builtin_amdgcn_mfma_f32_32x32x16_bf16(dA[0], i0, o, 0, 0, 0); o = __builtin_amdgcn_mfma_f32_32x32x16_bf16(dA[1], i1, o, 0, 0, 0);
            const bf16x8 sb0 = cvt8(S, 0), sb1 = cvt8(S, 8);
            o = __builtin_amdgcn_mfma_f32_32x32x16_bf16(qf[0], sb0, o, 0, 0, 0); o = __builtin_amdgcn_mfma_f32_32x32x16_bf16(qf[1], sb1, o, 0, 0, 0);
            S = __builtin_amdgcn_mfma_f32_32x32x16_bf16(kT[0], i0, S, 0, 0, 0); S = __builtin_amdgcn_mfma_f32_32x32x16_bf16(kT[1], i1, S, 0, 0, 0);
#pragma unroll
            for (int r = 0; r < 16; ++r) S[r] *= eC[r];
            LAS unsigned char* pp = lds + OFF_P + ((u * 4 + w) * 64 + 32 * i + c) * PSTR + 8 * hh;
#pragma unroll
            for (int g = 0; g < 4; ++g) { u32x2 wv; wv.x = cvt_pk_bf16(o[4 * g], o[4 * g + 1]); wv.y = cvt_pk_bf16(o[4 * g + 2], o[4 * g + 3]); *(LAS u32x2*)(pp + 16 * g) = wv; }
        }
        if (ch + 1 < SEQ / 32) HG_SWRITE((ch + 1) & 1);
        __syncthreads();
        {
            float oa[4] = {0.f, 0.f, 0.f, 0.f}, ob[4] = {0.f, 0.f, 0.f, 0.f};
#pragma unroll
            for (int ww = 0; ww < 4; ++ww) {
                const u32x2 pa = *(const LAS u32x2*)(lds + OFF_P + ((0 * 4 + ww) * 64 + lane) * PSTR + 8 * wid), pb = *(const LAS u32x2*)(lds + OFF_P + ((1 * 4 + ww) * 64 + lane) * PSTR + 8 * wid);
                oa[0] += lo_bf(pa.x); oa[1] += hi_bf(pa.x); oa[2] += lo_bf(pa.y); oa[3] += hi_bf(pa.y);
                ob[0] += lo_bf(pb.x); ob[1] += hi_bf(pb.x); ob[2] += lo_bf(pb.y); ob[3] += hi_bf(pb.y); }
#pragma unroll
            for (int k = 0; k < 4; ++k) { const float rs = rsqrtf(wave_sum(oa[k] * oa[k] + ob[k] * ob[k]) * (1.0f / 128.0f) + NORM_EPS);
                bf16_t* op = ohg + (row0 + (size_t)ch * 32 + 4 * wid + k) * 1024 + h * 128;
                op[lane] = (bf16_t)f2bf(oa[k] * rs * g_a); op[64 + lane] = (bf16_t)f2bf(ob[k] * rs * g_b); }
        }
        __syncthreads();
    }
#undef HG_GLOAD
#undef HG_SWRITE
}
}
__global__ __launch_bounds__(512, 2) void k_hgrn(const bf16_t* zq, const bf16_t* lf, const bf16_t* kk, const bf16_t* zi, bf16_t* ohg, const float* gain) {
    extern __shared__ __attribute__((aligned(16))) unsigned char shm[];
    for (int bh = blockIdx.x; bh < 64; bh += gridDim.x) hg::hgrn_bh(bh >> 3, bh & 7, zq, lf, kk, zi, ohg, gain, (LAS unsigned char*)shm);
}

struct RwkvP { const bf16_t *zr, *zk, *zv, *zl; bf16_t* vf; bf16_t* out; const float *mu, *vmu, *w0, *wup, *a0, *aup, *gup, *v0, *vup, *kk_, *ka, *rk, *lng, *lnb; int layer; };
__global__ __launch_bounds__(64) void k_rwkv_slow(RwkvP P) {
    extern __shared__ float sh[];
    float* Lw = sh;
    float* La = Lw + 64 * 64;
    float* Lg = La + 64 * 64;
    float* Lv = Lg + 128 * 64;
    float* s_lw = Lv + 32 * 64;
    float* s_la = s_lw + 64; float* s_lg = s_la + 64; float* s_lv = s_lg + 128;
    float* s_r = s_lv + 32; float* s_w = s_r + 64; float* s_k = s_w + 64; float* s_kk = s_k + 64; float* s_ka = s_kk + 64;
    const int b = blockIdx.x >> 4, h = blockIdx.x & 15, j = threadIdx.x, c = h * 64 + j;
    for (int i = 0; i < 64; ++i) { Lw[i * 64 + j] = P.wup[(size_t)i * 1024 + c]; La[i * 64 + j] = P.aup[(size_t)i * 1024 + c]; }
    for (int i = 0; i < 128; ++i) Lg[i * 64 + j] = P.gup[(size_t)i * 1024 + c];
    if (P.layer == 1) for (int i = 0; i < 32; ++i) Lv[i * 64 + j] = P.vup[(size_t)i * 1024 + c];
    const float mu_r = P.mu[c], mu_k = P.mu[1024 + c], mu_v = P.mu[2048 + c], mu_w = P.mu[3072 + j], mu_a = P.mu[3136 + j], mu_g0 = P.mu[3200 + j], mu_g1 = P.mu[3264 + j];
    const float mu_vr = (P.layer == 1 && j < 32) ? P.vmu[j] : 0.f;
    const float w0 = P.w0[c], a0 = P.a0[c], v0 = P.layer == 1 ? P.v0[c] : 0.f, k_k = P.kk_[c], k_a = P.ka[c], r_k = P.rk[c], lng = P.lng[c], lnb = P.lnb[c];
    float S[64];
#pragma unroll
    for (int k = 0; k < 64; ++k) S[k] = 0.f;
    float pr = 0.f, pk = 0.f, pv = 0.f, plw = 0.f, pla = 0.f, plg0 = 0.f, plg1 = 0.f, plv = 0.f;
    __syncthreads();
    for (int t = 0; t < SEQ; ++t) {
        const size_t row = (size_t)b * SEQ + t;
        const float zr = bf2f(P.zr[row * 1024 + c]), zk = bf2f(P.zk[row * 1024 + c]), zv = bf2f(P.zv[row * 1024 + c]);
        const float lw = bf2f(P.zl[row * 512 + j]), la = bf2f(P.zl[row * 512 + 64 + j]), lg0 = bf2f(P.zl[row * 512 + 128 + j]), lg1 = bf2f(P.zl[row * 512 + 192 + j]);
        const float lv = (j < 32) ? bf2f(P.zl[row * 512 + 256 + j]) : 0.f;
        const float r = zr + (pr - zr) * mu_r; float k = zk + (pk - zk) * mu_k; float v = zv + (pv - zv) * mu_v;
        s_lw[j] = tanhf(lw + (plw - lw) * mu_w); s_la[j] = la + (pla - la) * mu_a;
        s_lg[j] = sigmoidf_(lg0 + (plg0 - lg0) * mu_g0); s_lg[64 + j] = sigmoidf_(lg1 + (plg1 - lg1) * mu_g1);
        if (j < 32) s_lv[j] = lv + (plv - lv) * mu_vr;
        pr = zr; pk = zk; pv = zv; plw = lw; pla = la; plg0 = lg0; plg1 = lg1; plv = lv;
        __syncthreads();
        float wl = w0, al = a0, g = 0.f, vl = v0;
#pragma unroll 4
        for (int i = 0; i < 64; ++i) { wl += s_lw[i] * Lw[i * 64 + j]; al += s_la[i] * La[i * 64 + j]; }
#pragma unroll 4
        for (int i = 0; i < 128; ++i) g += s_lg[i] * Lg[i * 64 + j];
        if (P.layer == 1) {
#pragma unroll 4
            for (int i = 0; i < 32; ++i) vl += s_lv[i] * Lv[i * 64 + j];
            const float vf = bf2f(P.vf[row * 1024 + c]); v = v + (vf - v) * sigmoidf_(vl);
        } else P.vf[row * 1024 + c] = (bf16_t)f2bf(v);
        const float nx = -wl, sp = fmaxf(nx, 0.f) + log1pf(__expf(-fabsf(nx)));
        const float decay = __expf(-__expf(-sp - 0.5f));
        const float a = sigmoidf_(al);
        const float kkv = k * k_k; const float nrm = wave_sum(kkv * kkv); const float kk = kkv * rsqrtf(fmaxf(nrm, 1e-24f));
        k = k * (1.0f + (a - 1.0f) * k_a);
        s_r[j] = r; s_w[j] = decay; s_k[j] = k; s_kk[j] = kk; s_ka[j] = kk * a;
        const float bon = wave_sum(r * k * r_k);
        __syncthreads();
        float sa = 0.f;
#pragma unroll
        for (int q = 0; q < 64; q += 4) { const f32x4 kq = *(const f32x4*)(s_kk + q); sa -= S[q] * kq[0] + S[q + 1] * kq[1] + S[q + 2] * kq[2] + S[q + 3] * kq[3]; if ((q & 15) == 12) asm volatile("" ::: "memory"); }
        float y = 0.f;
#pragma unroll
        for (int q = 0; q < 64; q += 4) { const f32x4 wq = *(const f32x4*)(s_w + q), aq = *(const f32x4*)(s_ka + q), kq = *(const f32x4*)(s_k + q), rq = *(const f32x4*)(s_r + q);
#pragma unroll
            for (int e = 0; e < 4; ++e) { S[q + e] = S[q + e] * wq[e] + sa * aq[e] + v * kq[e]; y += S[q + e] * rq[e]; }
            asm volatile("" ::: "memory"); }
        const float mean = wave_sum(y) * (1.0f / 64.0f); const float dv = y - mean; const float var = wave_sum(dv * dv) * (1.0f / 64.0f);
        const float yn = dv * rsqrtf(var + 64e-5f) * lng + lnb;
        P.out[row * 1024 + c] = (bf16_t)f2bf((yn + bon * v) * g);
    }
}

namespace rw {
typedef float f32x16 __attribute__((ext_vector_type(16)));
constexpr int OFF_OP = 0, OFF_VV = 40960, OFF_GG = 49152, OFF_YY = 57344, OFF_WL = 65536, OFF_AL = 73728, OFF_VL = 81920, OFF_BON = 90112, OFF_X = 90240, XSTR = 592, LDS_BYTES = OFF_X + 32 * XSTR;
__device__ __forceinline__ int crow(int r, int hi) { return (r & 3) + 8 * (r >> 2) + 4 * hi; }
template <int CTRL> __device__ __forceinline__ float dppf(float x) { return __builtin_bit_cast(float, __builtin_amdgcn_update_dpp(0, __builtin_bit_cast(int, x), CTRL, 0xF, 0xF, true)); }
__device__ __forceinline__ float sum16(float x) { x += dppf<0xB1>(x); x += dppf<0x4E>(x); x += dppf<0x141>(x); x += dppf<0x140>(x); return x; }
__device__ __forceinline__ f32x4 ld4bf(const bf16_t* p) { const u32x2 w = *(const u32x2*)p; return (f32x4){lo_bf(w.x), hi_bf(w.x), lo_bf(w.y), hi_bf(w.y)}; }
__device__ __forceinline__ float fast_tanh(float x) { const float t = __expf(2.0f * x); return 1.0f - 2.0f / (t + 1.0f); }

__device__ __forceinline__ void rwkv_head(int b, int h, const RwkvP& P, LAS unsigned char* lds) {
    const int tid = threadIdx.x, wid = __builtin_amdgcn_readfirstlane(tid >> 6), lane = tid & 63, c = lane & 31, hh = lane >> 5;
    const int layer = P.layer;
    const size_t row0 = (size_t)b * SEQ;
    const int et = tid >> 4, eq = tid & 15, ch0 = h * 64 + 4 * eq;
    const f32x4 mu_r = *(const f32x4*)(P.mu + ch0), mu_k = *(const f32x4*)(P.mu + 1024 + ch0), mu_v = *(const f32x4*)(P.mu + 2048 + ch0);
    const f32x4 mu_w = *(const f32x4*)(P.mu + 3072 + 4 * eq), mu_a = *(const f32x4*)(P.mu + 3136 + 4 * eq), mu_g0 = *(const f32x4*)(P.mu + 3200 + 8 * eq), mu_g1 = *(const f32x4*)(P.mu + 3204 + 8 * eq);
    const float mu_x0 = layer ? P.vmu[2 * eq] : 0.f, mu_x1 = layer ? P.vmu[2 * eq + 1] : 0.f;
    const f32x4 w0 = *(const f32x4*)(P.w0 + ch0), a0 = *(const f32x4*)(P.a0 + ch0), k_k = *(const f32x4*)(P.kk_ + ch0), k_a = *(const f32x4*)(P.ka + ch0), r_k = *(const f32x4*)(P.rk + ch0),
                lng = *(const f32x4*)(P.lng + ch0), lnb = *(const f32x4*)(P.lnb + ch0);
    f32x4 v0 = (f32x4){0.f, 0.f, 0.f, 0.f}; if (layer) v0 = *(const f32x4*)(P.v0 + ch0);
    const int ltype = wid >> 1, nt = wid & 1;
    const int nks = ltype == 2 ? 8 : ltype == 3 ? 2 : 4, xcol = ltype == 0 ? 0 : ltype == 1 ? 64 : ltype == 2 ? 128 : 256;
    const float* wsrc = ltype == 0 ? P.wup : ltype == 1 ? P.aup : ltype == 2 ? P.gup : P.vup;
    bf16x8 Bf[8];
#pragma unroll
    for (int ks = 0; ks < 8; ++ks) {
#pragma unroll
        for (int j = 0; j < 8; ++j) Bf[ks][j] = 0;
        if (ks < nks && (ltype != 3 || layer)) {
#pragma unroll
            for (int j = 0; j < 8; ++j) Bf[ks][j] = (short)f2bf(wsrc[(size_t)(16 * ks + 8 * hh + j) * 1024 + h * 64 + 32 * nt + c]); }
    }
    const int dst_off = ltype == 0 ? OFF_WL : ltype == 1 ? OFF_AL : ltype == 2 ? OFF_GG : OFF_VL;
    const int rp = tid >> 4, kq = tid & 15;
    f32x4 Sa = (f32x4){0.f, 0.f, 0.f, 0.f}, Sb = (f32x4){0.f, 0.f, 0.f, 0.f};
    __syncthreads();
    for (int t0 = 0; t0 < SEQ; t0 += 32) {
        const size_t row = row0 + t0 + et; const bool first = (t0 + et) == 0;
        f32x4 r4, k4, v4, kk4;
        {
            const f32x4 zr = ld4bf(P.zr + row * 1024 + ch0), zk = ld4bf(P.zk + row * 1024 + ch0), zv = ld4bf(P.zv + row * 1024 + ch0);
            f32x4 pr = (f32x4){0.f, 0.f, 0.f, 0.f}, pk = pr, pv = pr;
            if (!first) { pr = ld4bf(P.zr + (row - 1) * 1024 + ch0); pk = ld4bf(P.zk + (row - 1) * 1024 + ch0); pv = ld4bf(P.zv + (row - 1) * 1024 + ch0); }
            r4 = zr + (pr - zr) * mu_r; k4 = zk + (pk - zk) * mu_k; v4 = zv + (pv - zv) * mu_v;
            const f32x4 kkv = k4 * k_k;
            const float nrm = sum16(kkv[0] * kkv[0] + kkv[1] * kkv[1] + kkv[2] * kkv[2] + kkv[3] * kkv[3]);
            kk4 = kkv * rsqrtf(fmaxf(nrm, 1e-24f));
            const bf16_t* zl = P.zl + row * 512; const bf16_t* zlp = P.zl + (row - 1) * 512;
            f32x4 lw = ld4bf(zl + 4 * eq), la = ld4bf(zl + 64 + 4 * eq), lg0 = ld4bf(zl + 128 + 8 * eq), lg1 = ld4bf(zl + 132 + 8 * eq);
            const unsigned lxw = *(const unsigned*)(zl + 256 + 2 * eq);
            f32x4 pw = (f32x4){0.f, 0.f, 0.f, 0.f}, pa = pw, pg0 = pw, pg1 = pw; unsigned pxw = 0u;
            if (!first) { pw = ld4bf(zlp + 4 * eq); pa = ld4bf(zlp + 64 + 4 * eq); pg0 = ld4bf(zlp + 128 + 8 * eq); pg1 = ld4bf(zlp + 132 + 8 * eq); pxw = *(const unsigned*)(zlp + 256 + 2 * eq); }
            lw = lw + (pw - lw) * mu_w; la = la + (pa - la) * mu_a; lg0 = lg0 + (pg0 - lg0) * mu_g0; lg1 = lg1 + (pg1 - lg1) * mu_g1;
            const float lx0 = lo_bf(lxw) + (lo_bf(pxw) - lo_bf(lxw)) * mu_x0, lx1 = hi_bf(lxw) + (hi_bf(pxw) - hi_bf(lxw)) * mu_x1;
            LAS unsigned char* xr = lds + OFF_X + et * XSTR;
            u32x2 ww; ww.x = cvt_pk_bf16(fast_tanh(lw[0]), fast_tanh(lw[1])); ww.y = cvt_pk_bf16(fast_tanh(lw[2]), fast_tanh(lw[3])); *(LAS u32x2*)(xr + (4 * eq) * 2) = ww;
            u32x2 wa; wa.x = cvt_pk_bf16(la[0], la[1]); wa.y = cvt_pk_bf16(la[2], la[3]); *(LAS u32x2*)(xr + (64 + 4 * eq) * 2) = wa;
            u32x4 wg; wg.x = cvt_pk_bf16(sigmoidf_(lg0[0]), sigmoidf_(lg0[1])); wg.y = cvt_pk_bf16(sigmoidf_(lg0[2]), sigmoidf_(lg0[3])); wg.z = cvt_pk_bf16(sigmoidf_(lg1[0]), sigmoidf_(lg1[1])); wg.w = cvt_pk_bf16(sigmoidf_(lg1[2]), sigmoidf_(lg1[3]));
            *(LAS u32x4*)(xr + (128 + 8 * eq) * 2) = wg;
            *(LAS unsigned*)(xr + (256 + 2 * eq) * 2) = cvt_pk_bf16(lx0, lx1);
        }
        __syncthreads();
        {
            f32x16 acc;
#pragma unroll
            for (int r = 0; r < 16; ++r) acc[r] = 0.f;
            const LAS unsigned char* xa = lds + OFF_X + c * XSTR + (xcol + 8 * hh) * 2;
#pragma unroll
            for (int ks = 0; ks < 8; ++ks) if (ks < nks) { const bf16x8 a = *(const LAS bf16x8*)(xa + 32 * ks); acc = __builtin_amdgcn_mfma_f32_32x32x16_bf16(a, Bf[ks], acc, 0, 0, 0); }
            LAS float* dp = (LAS float*)(lds + dst_off) + 32 * nt + c;
#pragma unroll
            for (int r = 0; r < 16; ++r) dp[crow(r, hh) * 64] = acc[r];
        }
        __syncthreads();
        {
            const f32x4 wl = w0 + *(const LAS f32x4*)(lds + OFF_WL + (et * 64 + 4 * eq) * 4), al = a0 + *(const LAS f32x4*)(lds + OFF_AL + (et * 64 + 4 * eq) * 4);
            f32x4 dec, av;
#pragma unroll
            for (int e = 0; e < 4; ++e) { const float nx = -wl[e], sp = fmaxf(nx, 0.f) + __logf(1.0f + __expf(-fabsf(nx))); dec[e] = __expf(-__expf(-sp - 0.5f)); av[e] = sigmoidf_(al[e]); }
            if (layer) { const f32x4 vl = v0 + *(const LAS f32x4*)(lds + OFF_VL + (et * 64 + 4 * eq) * 4); const f32x4 vf = ld4bf(P.vf + row * 1024 + ch0);
#pragma unroll
                for (int e = 0; e < 4; ++e) v4[e] = v4[e] + (vf[e] - v4[e]) * sigmoidf_(vl[e]);
            } else { u32x2 wv; wv.x = cvt_pk_bf16(v4[0], v4[1]); wv.y = cvt_pk_bf16(v4[2], v4[3]); *(u32x2*)(P.vf + row * 1024 + ch0) = wv; }
            const f32x4 k2 = k4 * (1.0f + (av - 1.0f) * k_a), ka = kk4 * av;
            const f32x4 rkk = r4 * k2 * r_k;
            const float bon = sum16((rkk[0] + rkk[1]) + (rkk[2] + rkk[3]));
            LAS float* op = (LAS float*)(lds + OFF_OP) + et * 320 + 4 * eq;
            *(LAS f32x4*)(op) = dec; *(LAS f32x4*)(op + 64) = -kk4; *(LAS f32x4*)(op + 128) = ka; *(LAS f32x4*)(op + 192) = k2; *(LAS f32x4*)(op + 256) = r4;
            *(LAS f32x4*)(lds + OFF_VV + (et * 64 + 4 * eq) * 4) = v4;
            if (eq == 0) *(LAS float*)(lds + OFF_BON + et * 4) = bon;
        }
        __syncthreads();
        {
            const LAS float* op = (const LAS float*)(lds + OFF_OP) + 4 * kq; const LAS float* vp = (const LAS float*)(lds + OFF_VV) + 2 * rp; LAS float* yp = (LAS float*)(lds + OFF_YY) + 2 * rp;
#pragma unroll 2
            for (int t = 0; t < 32; ++t) {
                const f32x4 w = *(const LAS f32x4*)(op + t * 320), nk = *(const LAS f32x4*)(op + t * 320 + 64), ka = *(const LAS f32x4*)(op + t * 320 + 128), kx = *(const LAS f32x4*)(op + t * 320 + 192), rr = *(const LAS f32x4*)(op + t * 320 + 256);
                const f32x2 vv2 = *(const LAS f32x2*)(vp + t * 64);
                float sa = (Sa[0] * nk[0] + Sa[1] * nk[1]) + (Sa[2] * nk[2] + Sa[3] * nk[3]);
                float sb = (Sb[0] * nk[0] + Sb[1] * nk[1]) + (Sb[2] * nk[2] + Sb[3] * nk[3]);
                sa = sum16(sa); sb = sum16(sb);
                Sa = Sa * w + sa * ka + vv2[0] * kx; Sb = Sb * w + sb * ka + vv2[1] * kx;
                float ya = (Sa[0] * rr[0] + Sa[1] * rr[1]) + (Sa[2] * rr[2] + Sa[3] * rr[3]);
                float yb = (Sb[0] * rr[0] + Sb[1] * rr[1]) + (Sb[2] * rr[2] + Sb[3] * rr[3]);
                ya = sum16(ya); yb = sum16(yb);
                if (kq == 0) *(LAS f32x2*)(yp + t * 64) = (f32x2){ya, yb};
            }
        }
        __syncthreads();
        {
            const f32x4 y = *(const LAS f32x4*)(lds + OFF_YY + (et * 64 + 4 * eq) * 4), g = *(const LAS f32x4*)(lds + OFF_GG + (et * 64 + 4 * eq) * 4);
            const float bon = *(const LAS float*)(lds + OFF_BON + et * 4);
            const float mean = sum16((y[0] + y[1]) + (y[2] + y[3])) * (1.0f / 64.0f);
            const f32x4 d = y - mean;
            const float var = sum16((d[0] * d[0] + d[1] * d[1]) + (d[2] * d[2] + d[3] * d[3])) * (1.0f / 64.0f);
            const f32x4 o = (d * rsqrtf(var + 64e-5f) * lng + lnb + bon * v4) * g;
            u32x2 wo; wo.x = cvt_pk_bf16(o[0], o[1]); wo.y = cvt_pk_bf16(o[2], o[3]);
            *(u32x2*)(P.out + row * 1024 + ch0) = wo;
        }
    }
}
}
__global__ __launch_bounds__(512, 2) void k_rwkv(RwkvP P) {
    extern __shared__ __attribute__((aligned(16))) unsigned char shm[];
    for (int bh = blockIdx.x; bh < 128; bh += gridDim.x) rw::rwkv_head(bh >> 4, bh & 15, P, (LAS unsigned char*)shm);
}

template <class Epi> static void launch_gemm(hipStream_t st, const bf16_t* A, int lda, const bf16_t* Bt, int N, int K, const Epi& E) {
    static bool attr = false;
    if (!attr) { (void)hipFuncSetAttribute((const void*)k_gemm<Epi>, hipFuncAttributeMaxDynamicSharedMemorySize, 131072); attr = true; }
    Gemm g; g.A = A; g.Bt = Bt; g.M = T; g.N = N; g.K = K; g.lda = lda;
    hipLaunchKernelGGL(k_gemm<Epi>, dim3(256), dim3(512), 131072, st, g, E);
}

extern "C" void kernel_launch(void* const* d_in, const int* in_sizes, int n_in, void* d_out, int out_size, void* d_ws, size_t ws_size, hipStream_t stream) {
    if (n_in != 32 || ws_size < WS_END || out_size != T * D) { fprintf(stderr, "kernel_launch: unexpected shapes (n_in %d ws %zu out %d)\n", n_in, ws_size, out_size); return; }
    Params p{};
    for (int i = 0; i < 32; ++i) p.in[i] = (const float*)d_in[i];
    p.out = (float*)d_out; p.ws = (unsigned char*)d_ws;
    unsigned char* ws = (unsigned char*)d_ws;
    bf16_t* WB = (bf16_t*)(ws + WS_W);
    bf16_t* H = (bf16_t*)(ws + WS_H); bf16_t* VF = (bf16_t*)(ws + WS_VF); bf16_t* MG = (bf16_t*)(ws + WS_MG); bf16_t* XR = (bf16_t*)(ws + WS_XR);
    bf16_t* ZA = (bf16_t*)(ws + WS_ZA); bf16_t* ZB = (bf16_t*)d_out;
    float* rope = (float*)(ws + WS_ROPE);
    const size_t TU = (size_t)T * 1024;
    static bool attr = false;
    if (!attr) { (void)hipFuncSetAttribute((const void*)k_weights, hipFuncAttributeMaxDynamicSharedMemorySize, 8 * 8704);
                 (void)hipFuncSetAttribute((const void*)k_attn, hipFuncAttributeMaxDynamicSharedMemorySize, att::LDS_BYTES);
                 (void)hipFuncSetAttribute((const void*)k_hgrn, hipFuncAttributeMaxDynamicSharedMemorySize, hg::LDS_BYTES);
                 (void)hipFuncSetAttribute((const void*)k_rwkv, hipFuncAttributeMaxDynamicSharedMemorySize, rw::LDS_BYTES);
                 (void)hipFuncSetAttribute((const void*)k_rwkv_slow, hipFuncAttributeMaxDynamicSharedMemorySize, 96 * 1024); attr = true; }
    const float qscale = 0.07216878364870322f * 1.4426950408889634f;
    hipLaunchKernelGGL(k_rope, dim3(T * 32 / 256), dim3(256), 0, stream, p);
    hipLaunchKernelGGL(k_norm0, dim3(T / 4), dim3(256), 0, stream, p.in[0], p.in[3], H);
    for (int l = 0; l < 2; ++l) {
        hipLaunchKernelGGL(k_weights, dim3(256), dim3(512), 8 * 8704, stream, p, l);
        bf16_t* zmla = ZB; bf16_t* krope = ZB + (size_t)T * 768; bf16_t* qn = ZA; bf16_t* qr = ZB + TU; bf16_t* kn = ZA + TU; bf16_t* vv = ZA + 2 * TU;
        { EpiRoute E{zmla, 0, zmla, 768, 768, 16, 99, 1.0f, 0}; launch_gemm(stream, H, 1024, WB + W_MLA, 768, 1024, E); }
        hipLaunchKernelGGL(k_mla_prep, dim3(T / 4), dim3(256), 0, stream, zmla, p.in[24] + l * 384, p.in[26] + l * 256, rope, krope);
        { EpiQ E{qn, qr, rope, qscale, 0}; launch_gemm(stream, zmla, 768, WB + W_UQ, 1536, 384, E); }
        { EpiRoute E{kn, (long)TU, kn, 1024, 1024, 4, 99, 1.0f, 0}; launch_gemm(stream, zmla + 384, 768, WB + W_UKV, 2048, 256, E); }
        hipLaunchKernelGGL(k_attn, dim3(256), dim3(512), att::LDS_BYTES, stream, qn, qr, kn, krope, vv);
        { bf16_t* GT = ZB;
          EpiEw<0> Eg{GT, nullptr}; launch_gemm(stream, H, 1024, WB + W_GATE + 2 * KE * KE, 1024, 1024, Eg);
          EpiEw<2> Eb{MG, GT}; launch_gemm(stream, qn, 1024, WB + W_BR + 2 * KE * KE, 1024, 1024, Eb); }
        { bf16_t* zr = ZA; bf16_t* zk = ZA + TU; bf16_t* zv = ZA + 2 * TU; bf16_t* zl = ZB; bf16_t* orw = ZB + TU;
          EpiRoute E{zr, (long)TU, zl, 1024, 512, 4, 3, 1.0f, 0}; launch_gemm(stream, H, 1024, WB + W_RW, 3584, 1024, E);
          RwkvP R{}; R.zr = zr; R.zk = zk; R.zv = zv; R.zl = zl; R.vf = VF; R.out = orw; R.mu = p.in[10] + l * 3328; R.vmu = p.in[11]; R.w0 = p.in[12] + l * 1024; R.wup = p.in[13] + (size_t)l * 64 * 1024;
          R.a0 = p.in[14] + l * 1024; R.aup = p.in[15] + (size_t)l * 64 * 1024; R.gup = p.in[16] + (size_t)l * 128 * 1024; R.v0 = p.in[17]; R.vup = p.in[18];
          R.kk_ = p.in[19] + l * 1024; R.ka = p.in[20] + l * 1024; R.rk = p.in[21] + l * 1024; R.lng = p.in[22] + l * 1024; R.lnb = p.in[23] + l * 1024; R.layer = l;
          hipLaunchKernelGGL(k_rwkv, dim3(128), dim3(512), rw::LDS_BYTES, stream, R);
          bf16_t* GT = ZA;
          EpiEw<0> Eg{GT, nullptr}; launch_gemm(stream, H, 1024, WB + W_GATE + 1 * KE * KE, 1024, 1024, Eg);
          EpiEw<3> Eb{MG, GT}; launch_gemm(stream, orw, 1024, WB + W_BR + 1 * KE * KE, 1024, 1024, Eb); }
        { bf16_t* zq = ZA; bf16_t* zf = ZA + TU; bf16_t* zi = ZA + 2 * TU; bf16_t* ohg = ZB;
          EpiRoute E{zq, (long)TU, zq, 1024, 1024, 4, 99, 1.0f, 0}; launch_gemm(stream, H, 1024, WB + W_HG, 3072, 1024, E);
          hipLaunchKernelGGL(k_hgrn_prep, dim3((unsigned)(TU / 2 / 256)), dim3(256), 0, stream, zf, ZB + TU, p.in[2], l);
          hipLaunchKernelGGL(k_hgrn, dim3(64), dim3(512), hg::LDS_BYTES, stream, zq, zf, ZB + TU, zi, ohg, p.in[9] + l * 128);
          EpiEw<1> Eo{ohg, nullptr}; launch_gemm(stream, H, 1024, WB + W_OG, 1024, 1024, Eo);
          bf16_t* GT = ZA;
          EpiEw<0> Eg{GT, nullptr}; launch_gemm(stream, H, 1024, WB + W_GATE, 1024, 1024, Eg);
          EpiEw<3> Eb{MG, GT}; launch_gemm(stream, ohg, 1024, WB + W_BR, 1024, 1024, Eb); }
        { bf16_t* y = ZA;
          EpiRoute E{y, 0, y, 1024, 1024, 16, 99, 1.0f, 0}; launch_gemm(stream, MG, 1024, WB + W_OUT, 1024, 1024, E);
          hipLaunchKernelGGL(k_normres, dim3(T / 4), dim3(256), 0, stream, y, l == 0 ? p.in[0] : (const float*)nullptr, XR, p.in[4] + l * 1024, XR, (float*)nullptr, p.in[5] + l * 1024, H);
          bf16_t* hid = ZA;
          EpiSwiglu Es{hid}; launch_gemm(stream, H, 1024, WB + W_FI, 5632, 1024, Es);
          bf16_t* y2 = MG;
          EpiRoute E2{y2, 0, y2, 1024, 1024, 16, 99, 1.0f, 0}; launch_gemm(stream, hid, 2816, WB + W_FO, 1024, 2816, E2);
          if (l == 0) hipLaunchKernelGGL(k_normres, dim3(T / 4), dim3(256), 0, stream, y2, (const float*)nullptr, XR, p.in[6] + l * 1024, XR, (float*)nullptr, p.in[3] + 1024, H);
          else hipLaunchKernelGGL(k_normres, dim3(T / 4), dim3(256), 0, stream, y2, (const float*)nullptr, XR, p.in[6] + l * 1024, (bf16_t*)nullptr, (float*)d_out, (const float*)nullptr, (bf16_t*)nullptr); }
    }
}
static_assert(sizeof(EpiRoute) == 48 && sizeof(EpiQ) == 32 && sizeof(Gemm) == 32 && sizeof(EpiEw<0>) == 16 && sizeof(EpiSwiglu) == 8, "no padding bytes in by-value kernel arguments");
```
